# Optimizing an MI355X kernel written in HIP

```python
import jax, jax.numpy as jnp
from jax import lax
import numpy as np

D_MODEL = 1024
BATCH = 8
SEQ = 4096
DEPTH = 2

D_MIX = D_MODEL
CONV_W = D_MIX // 4
POOL_W = D_MIX // 4
ATTN_W = D_MIX - CONV_W - POOL_W
HEAD_DIM = 64
N_HEADS = ATTN_W // HEAD_DIM
CONV_K = 31
POOL_WINDOWS = (2, 4, 8, 16)
N_POOL_GROUPS = len(POOL_WINDOWS)
POOL_GROUP = POOL_W // N_POOL_GROUPS
GRID_W = 64
WIN_R_MAX = 8
WIN_C = 16
Q_COLS = WIN_C
K_COLS = 2 * WIN_C
D_FF = ((8 * D_MODEL // 3 + 127) // 128) * 128
IN_W = 2 * CONV_W + POOL_W + 3 * ATTN_W
EPS = 1e-6
NEG = -1e30

kernel_name = 'hybrid_conv_pool_natten_macaron_encoder'


def rmsnorm(x, g):
    x32 = x.astype(jnp.float32)
    y = x32 * lax.rsqrt(jnp.mean(x32 * x32, axis=-1, keepdims=True) + EPS)
    return (y * g.astype(jnp.float32)).astype(x.dtype)


def layernorm(x, g, b):
    x32 = x.astype(jnp.float32)
    mu = jnp.mean(x32, axis=-1, keepdims=True)
    var = jnp.mean(jnp.square(x32 - mu), axis=-1, keepdims=True)
    y = (x32 - mu) * lax.rsqrt(var + EPS)
    return (y * g.astype(jnp.float32) + b.astype(jnp.float32)).astype(x.dtype)


def swiglu(h, w_gate, w_up, w_down):
    return (jax.nn.silu(h @ w_gate) * (h @ w_up)) @ w_down


def conv_module(a, gate, dw, dw_b, ln_g, ln_b, pw):
    u = a * jax.nn.sigmoid(gate)
    u = lax.conv_general_dilated(
        u, dw[:, None, :], window_strides=(1,),
        padding=[(CONV_K // 2, CONV_K // 2)],
        dimension_numbers=('NWC', 'WIO', 'NWC'),
        feature_group_count=u.shape[-1]) + dw_b
    u = jax.nn.silu(layernorm(u, ln_g, ln_b))
    return u @ pw


def pool_mixer(p, w_group, scale):
    b, s, _ = p.shape
    pg = p.reshape(b, s, N_POOL_GROUPS, POOL_GROUP)
    csum = jnp.concatenate(
        [jnp.zeros((b, 1, N_POOL_GROUPS, POOL_GROUP), jnp.float32),
         jnp.cumsum(pg.astype(jnp.float32), axis=1)], axis=1)
    t = jnp.arange(s)
    means = []
    for gi, w in enumerate(POOL_WINDOWS):
        lo = jnp.clip(t - w // 2, 0, s)
        hi = jnp.clip(t - w // 2 + w, 0, s)
        win_sum = csum[:, hi, gi] - csum[:, lo, gi]
        means.append(win_sum / (hi - lo).astype(jnp.float32)[:, None])
    pooled = jnp.stack(means, axis=2)
    mixed = (pooled - pg.astype(jnp.float32)).astype(p.dtype)
    y = jnp.einsum('bsgc,gcd->bsgd', mixed, w_group).reshape(b, s, POOL_W)
    return y * scale


def _column_blocks():
    n_cb = GRID_W // Q_COLS
    qcol = np.arange(GRID_W).reshape(n_cb, Q_COLS)
    kstart = np.clip(np.arange(n_cb) * Q_COLS - WIN_C // 2, 0, GRID_W - K_COLS)
    kcol = kstart[:, None] + np.arange(K_COLS)
    c0 = np.clip(qcol - WIN_C // 2, 0, GRID_W - WIN_C)
    valid = (kcol[:, None, :] >= c0[:, :, None]) & (kcol[:, None, :] < c0[:, :, None] + WIN_C)
    dc_idx = np.clip(kcol[:, None, :] - qcol[:, :, None] + WIN_C - 1, 0, 2 * WIN_C - 2)
    return kcol, valid, dc_idx


def neighbourhood_attention(q, k, v, rpb):
    b, s, h, d = q.shape
    rows = s // GRID_W
    kr = min(WIN_R_MAX, rows)
    kcol, valid, dc_idx = _column_blocks()
    n_cb = kcol.shape[0]
    qg = q.reshape(b, rows, n_cb, Q_COLS, h, d).transpose(1, 0, 4, 2, 3, 5)
    kg = k.reshape(b, rows, GRID_W, h, d).transpose(0, 3, 1, 2, 4)
    vg = v.reshape(b, rows, GRID_W, h, d).transpose(0, 3, 1, 2, 4)
    scale = HEAD_DIM ** -0.5
    mask = jnp.asarray(valid)[:, :, None, :]

    def one_row(args):
        q_r, r = args
        r0 = jnp.clip(r - kr // 2, 0, rows - kr)
        k_blk = lax.dynamic_slice_in_dim(kg, r0, kr, axis=2)[:, :, :, kcol]
        v_blk = lax.dynamic_slice_in_dim(vg, r0, kr, axis=2)[:, :, :, kcol]
        sc = jnp.einsum('bhnqd,bhinjd->bhnqij', q_r.astype(jnp.float32),
                        k_blk.astype(jnp.float32)) * scale
        dr_idx = r0 + jnp.arange(kr) - r + WIN_R_MAX - 1
        bias = jnp.take(rpb, dr_idx, axis=1)[:, :, dc_idx]
        bias = bias.transpose(0, 2, 3, 1, 4).astype(jnp.float32)
        sc = jnp.where(mask, sc + bias, NEG)
        p = jax.nn.softmax(sc.reshape(b, h, n_cb, Q_COLS, kr * K_COLS), axis=-1).reshape(sc.shape)
        return jnp.einsum('bhnqij,bhinjd->bhnqd', p.astype(v_blk.dtype), v_blk)

    out = lax.map(one_row, (qg, jnp.arange(rows)))
    return out.transpose(1, 0, 3, 4, 2, 5).reshape(b, s, h * d)


def setup_inputs(seed: int = 0) -> dict:
    key = jax.random.key(seed)
    ks = jax.random.split(key, 24)
    f32 = jnp.float32

    def nrm(k, shape, scale):
        return jax.random.normal(k, shape, f32) * scale

    def gain(k, shape):
        return 1.0 + 0.05 * jax.random.normal(k, shape, f32)

    L = DEPTH
    return {
        'x': jax.random.normal(ks[0], (BATCH, SEQ, D_MODEL), f32),
        'ffn1_norm': gain(ks[1], (L, D_MODEL)),
        'ffn1_gate': nrm(ks[2], (L, D_MODEL, D_FF), D_MODEL ** -0.5),
        'ffn1_up': nrm(ks[3], (L, D_MODEL, D_FF), D_MODEL ** -0.5),
        'ffn1_down': nrm(ks[4], (L, D_FF, D_MODEL), D_FF ** -0.5),
        'mix_norm': gain(ks[5], (L, D_MODEL)),
        'w_in': nrm(ks[6], (L, D_MODEL, IN_W), D_MODEL ** -0.5),
        'conv_dw': nrm(ks[7], (L, CONV_K, CONV_W), CONV_K ** -0.5),
        'conv_dw_b': nrm(ks[8], (L, CONV_W), 0.02),
        'conv_ln_g': gain(ks[9], (L, CONV_W)),
        'conv_ln_b': nrm(ks[10], (L, CONV_W), 0.02),
        'conv_pw': nrm(ks[11], (L, CONV_W, CONV_W), CONV_W ** -0.5),
        'pool_w': nrm(ks[12], (L, N_POOL_GROUPS, POOL_GROUP, POOL_GROUP), POOL_GROUP ** -0.5),
        'pool_scale': gain(ks[13], (L, POOL_W)),
        'q_norm': gain(ks[14], (L, HEAD_DIM)),
        'k_norm': gain(ks[15], (L, HEAD_DIM)),
        'rpb': nrm(ks[16], (L, N_HEADS, 2 * WIN_R_MAX - 1, 2 * WIN_C - 1), 0.1),
        'w_out': nrm(ks[17], (L, D_MIX, D_MODEL), D_MIX ** -0.5),
        'ffn2_norm': gain(ks[18], (L, D_MODEL)),
        'ffn2_gate': nrm(ks[19], (L, D_MODEL, D_FF), D_MODEL ** -0.5),
        'ffn2_up': nrm(ks[20], (L, D_MODEL, D_FF), D_MODEL ** -0.5),
        'ffn2_down': nrm(ks[21], (L, D_FF, D_MODEL), D_FF ** -0.5),
    }


def reference(x, ffn1_norm, ffn1_gate, ffn1_up, ffn1_down, mix_norm, w_in,
              conv_dw, conv_dw_b, conv_ln_g, conv_ln_b, conv_pw, pool_w, pool_scale,
              q_norm, k_norm, rpb, w_out, ffn2_norm, ffn2_gate, ffn2_up, ffn2_down):
    b, s, _ = x.shape
    splits = np.cumsum([CONV_W, CONV_W, POOL_W, ATTN_W, ATTN_W])
    for l in range(DEPTH):
        x = x + 0.5 * swiglu(rmsnorm(x, ffn1_norm[l]), ffn1_gate[l], ffn1_up[l], ffn1_down[l])
        h = rmsnorm(x, mix_norm[l])
        u = h @ w_in[l]
        c_a, c_g, p_in, q, k, v = jnp.split(u, splits, axis=-1)
        c_out = conv_module(c_a, c_g, conv_dw[l], conv_dw_b[l], conv_ln_g[l], conv_ln_b[l], conv_pw[l])
        p_out = pool_mixer(p_in, pool_w[l], pool_scale[l])
        q = rmsnorm(q.reshape(b, s, N_HEADS, HEAD_DIM), q_norm[l])
        k = rmsnorm(k.reshape(b, s, N_HEADS, HEAD_DIM), k_norm[l])
        v = v.reshape(b, s, N_HEADS, HEAD_DIM)
        a_out = neighbourhood_attention(q, k, v, rpb[l])
        x = x + jnp.concatenate([c_out, p_out, a_out], axis=-1) @ w_out[l]
        x = x + 0.5 * swiglu(rmsnorm(x, ffn2_norm[l]), ffn2_gate[l], ffn2_up[l], ffn2_down[l])
    return x
```

```cpp
#include <hip/hip_runtime.h>
#include <hip/hip_cooperative_groups.h>
#include <cstdio>
#include <cstdint>
namespace cg = cooperative_groups;
namespace pg8 {
#define PG8_LAS __attribute__((address_space(3)))
typedef unsigned short bf16_t;
typedef short bf16x8 __attribute__((ext_vector_type(8)));
typedef float f32x4 __attribute__((ext_vector_type(4)));
typedef unsigned u32x4 __attribute__((ext_vector_type(4)));
constexpr int BM = 256, BK = 64, HALF = 128, HTB = HALF * BK * 2  , STAGE_BYTES = 8 * HTB, NXCD = 8, WGM = 8;

__host__ __device__ __forceinline__ int lds_byte(int r, int c) { const int st = (r >> 4) * 2 + (c >> 5), rr = r & 15, cc = c & 31, ob = rr * 64 + cc * 2; return st * 1024 + (ob ^ (((ob >> 9) & 1) << 5)); }
__host__ __device__ __forceinline__ void stage_rc(int b, int& R, int& C) { const int st = b / 1024, sb = b % 1024, swz = sb ^ (((sb >> 9) & 1) << 5); R = (st >> 1) * 16 + swz / 64; C = (st & 1) * 32 + (swz % 64) / 2; }
__host__ __device__ __forceinline__ int perm32(int rho) { const int n = rho >> 4, i = rho & 15; return 8 * (i >> 2) + 4 * n + (i & 3); }

struct Unit { int pm, pn; };
struct Gemm { const bf16_t* A; const bf16_t* Bt; int M, N, K; };

struct StaticOrder {
    int nM, nN, nwg, G, c;
    __host__ __device__ void init(int M, int N, int G_, int c_) { nM = M / BM; nN = N / BM; nwg = nM * nN; G = G_; c = c_; }
    __host__ __device__ bool next(int i, Unit& u) const {
        const long L = (long)i * G + c; if (L >= nwg) return false;
        int wgid = (int)L; { const int q = nwg / NXCD, r = nwg % NXCD, xcd = wgid % NXCD, off = wgid / NXCD; wgid = (xcd < r ? xcd * (q + 1) : r * (q + 1) + (xcd - r) * q) + off; }
        const int nig = WGM * nN, gid = wgid / nig, fm = gid * WGM, gsz = (nM - fm) < WGM ? (nM - fm) : WGM;
        u.pm = fm + ((wgid % nig) % gsz); u.pn = (wgid % nig) / gsz; return true;
    }
    __device__ __forceinline__ void a_ready(const Unit&) const {}
    __device__ __forceinline__ void done(const Unit&) const {}
};

__device__ __forceinline__ unsigned cvt_pk_bf16(float lo, float hi) { unsigned r; asm volatile("v_cvt_pk_bf16_f32 %0, %1, %2" : "=v"(r) : "v"(lo), "v"(hi)); return r; }
typedef float f32x2 __attribute__((ext_vector_type(2)));
constexpr float NORM_EPS = 1e-6f;
__device__ __forceinline__ float fsigmoid(float x) { return __builtin_amdgcn_rcpf(1.0f + __expf(-x)); }
__device__ __forceinline__ float row_rstd(const float* ss, int row) { return rsqrtf(ss[row] * (1.0f / 1024.0f) + NORM_EPS); }

struct EpiSwiglu {
    static constexpr bool PERM = true, AFTER_DRAIN = false;
    bf16_t* H; int ldh; const float* ss;
    __device__ __forceinline__ void operator()(const f32x4 (&acc)[2][2][4][2], const Unit& u, int wr, int wc, int fr, int fq) const {
        const int row0 = u.pm * BM + wr * 64 + fr, col0 = u.pn * HALF + wc * 32 + 8 * fq;
#pragma unroll
        for (int ai = 0; ai < 2; ++ai)
#pragma unroll
            for (int m = 0; m < 4; ++m) { const int row = row0 + ai * HALF + m * 16; const float rs = row_rstd(ss, row);
                float h[8];
#pragma unroll
                for (int n = 0; n < 2; ++n)
#pragma unroll
                    for (int e = 0; e < 4; ++e) { const float g = acc[ai][0][m][n][e] * rs, up = acc[ai][1][m][n][e] * rs; h[4 * n + e] = g * fsigmoid(g) * up; }
                u32x4 w; w.x = cvt_pk_bf16(h[0], h[1]); w.y = cvt_pk_bf16(h[2], h[3]); w.z = cvt_pk_bf16(h[4], h[5]); w.w = cvt_pk_bf16(h[6], h[7]);
                *(u32x4*)(H + (size_t)row * ldh + col0) = w; }
    }
};
struct EpiResid {
    static constexpr bool PERM = true, AFTER_DRAIN = false;
    const float* base; float* out; bf16_t* xb; float* ssn; float alpha;
    __device__ __forceinline__ void operator()(const f32x4 (&acc)[2][2][4][2], const Unit& u, int wr, int wc, int fr, int fq) const {
        const int row0 = u.pm * BM + wr * 64 + fr, col0 = u.pn * BM + wc * 32 + 8 * fq;
#pragma unroll
        for (int ai = 0; ai < 2; ++ai)
#pragma unroll
            for (int m = 0; m < 4; ++m) { const int row = row0 + ai * HALF + m * 16; float part = 0.f;
#pragma unroll
                for (int bj = 0; bj < 2; ++bj) { const size_t off = (size_t)row * 1024 + col0 + bj * HALF;
                    const f32x4 b0 = *(const f32x4*)(base + off), b1 = *(const f32x4*)(base + off + 4);
                    const f32x4 o0 = b0 + acc[ai][bj][m][0] * alpha, o1 = b1 + acc[ai][bj][m][1] * alpha;
                    *(f32x4*)(out + off) = o0; *(f32x4*)(out + off + 4) = o1;
                    if (ssn) { u32x4 w; w.x = cvt_pk_bf16(o0[0], o0[1]); w.y = cvt_pk_bf16(o0[2], o0[3]); w.z = cvt_pk_bf16(o1[0], o1[1]); w.w = cvt_pk_bf16(o1[2], o1[3]);
                        *(u32x4*)(xb + off) = w;
                        part += (o0[0] * o0[0] + o0[1] * o0[1]) + (o0[2] * o0[2] + o0[3] * o0[3]) + (o1[0] * o1[0] + o1[1] * o1[1]) + (o1[2] * o1[2] + o1[3] * o1[3]); } }
                if (ssn) { part += __shfl_xor(part, 16); part += __shfl_xor(part, 32); if (fq == 0) unsafeAtomicAdd(ssn + row, part); } }
    }
};
struct EpiWin {
    static constexpr bool PERM = true, AFTER_DRAIN = false;
    bf16_t *CU, *P, *Q, *Kq; const float* ss; const float *qg, *kg;
    __device__ __forceinline__ void operator()(const f32x4 (&acc)[2][2][4][2], const Unit& u, int wr, int wc, int fr, int fq) const {
        const int row0 = u.pm * BM + wr * 64 + fr, pn = u.pn;
        if (pn < 2) {
#pragma unroll
            for (int ai = 0; ai < 2; ++ai)
#pragma unroll
                for (int m = 0; m < 4; ++m) { const int row = row0 + ai * HALF + m * 16; const float rs = row_rstd(ss, row); float h[8];
#pragma unroll
                    for (int n = 0; n < 2; ++n)
#pragma unroll
                        for (int e = 0; e < 4; ++e) { const float a = acc[ai][0][m][n][e] * rs, g = acc[ai][1][m][n][e] * rs; h[4 * n + e] = a * fsigmoid(g); }
                    u32x4 w; w.x = cvt_pk_bf16(h[0], h[1]); w.y = cvt_pk_bf16(h[2], h[3]); w.z = cvt_pk_bf16(h[4], h[5]); w.w = cvt_pk_bf16(h[6], h[7]);
                    *(u32x4*)(CU + (size_t)row * 256 + pn * HALF + wc * 32 + 8 * fq) = w; }
        } else if (pn == 2) {
#pragma unroll
            for (int ai = 0; ai < 2; ++ai)
#pragma unroll
                for (int m = 0; m < 4; ++m) { const int row = row0 + ai * HALF + m * 16; const float rs = row_rstd(ss, row);
#pragma unroll
                    for (int bj = 0; bj < 2; ++bj) { const f32x4 v0 = acc[ai][bj][m][0] * rs, v1 = acc[ai][bj][m][1] * rs;
                        u32x4 w; w.x = cvt_pk_bf16(v0[0], v0[1]); w.y = cvt_pk_bf16(v0[2], v0[3]); w.z = cvt_pk_bf16(v1[0], v1[1]); w.w = cvt_pk_bf16(v1[2], v1[3]);
                        *(u32x4*)(P + (size_t)row * 256 + bj * HALF + wc * 32 + 8 * fq) = w; } }
        } else {
            const int which = (pn - 3) >> 1, head = 4 * ((pn - 3) & 1) + wc;
            const float* gp = (which ? kg : qg) + 8 * fq; const float post = which ? 1.0f : 0.125f;
            f32x4 gv[2][2];
#pragma unroll
            for (int bj = 0; bj < 2; ++bj)
#pragma unroll
                for (int n = 0; n < 2; ++n) gv[bj][n] = *(const f32x4*)(gp + 32 * bj + 4 * n) * post;
            bf16_t* dst = (which ? Kq : Q) + head * 64 + 8 * fq;
#pragma unroll
            for (int ai = 0; ai < 2; ++ai)
#pragma unroll
                for (int m = 0; m < 4; ++m) { const int row = row0 + ai * HALF + m * 16; const float rs = row_rstd(ss, row);
                    f32x4 v[2][2]; float q = 0.f;
#pragma unroll
                    for (int bj = 0; bj < 2; ++bj)
#pragma unroll
                        for (int n = 0; n < 2; ++n) { v[bj][n] = acc[ai][bj][m][n] * rs; const f32x4 x = v[bj][n]; q += (x[0] * x[0] + x[1] * x[1]) + (x[2] * x[2] + x[3] * x[3]); }
                    q += __shfl_xor(q, 16); q += __shfl_xor(q, 32);
                    const float r2 = rsqrtf(q * (1.0f / 64.0f) + NORM_EPS);
#pragma unroll
                    for (int bj = 0; bj < 2; ++bj) { const f32x4 v0 = v[bj][0] * gv[bj][0] * r2, v1 = v[bj][1] * gv[bj][1] * r2;
                        u32x4 w; w.x = cvt_pk_bf16(v0[0], v0[1]); w.y = cvt_pk_bf16(v0[2], v0[3]); w.z = cvt_pk_bf16(v1[0], v1[1]); w.w = cvt_pk_bf16(v1[2], v1[3]);
                        *(u32x4*)(dst + (size_t)row * 512 + 32 * bj) = w; } }
        }
    }
};
struct EpiVT {
    static constexpr bool PERM = true, AFTER_DRAIN = false;
    bf16_t* VT; const float* ss; int ldv;
    __device__ __forceinline__ void operator()(const f32x4 (&acc)[2][2][4][2], const Unit& u, int wr, int wc, int fr, int fq) const {
        const int row0 = u.pm * BM + wr * 64 + fr, col0 = u.pn * BM + wc * 32 + 8 * fq;
        f32x4 rsv[2][2];
#pragma unroll
        for (int bj = 0; bj < 2; ++bj)
#pragma unroll
            for (int n = 0; n < 2; ++n) { const f32x4 s4 = *(const f32x4*)(ss + col0 + bj * HALF + 4 * n);
                rsv[bj][n] = (f32x4){rsqrtf(s4[0] * (1.0f / 1024.0f) + NORM_EPS), rsqrtf(s4[1] * (1.0f / 1024.0f) + NORM_EPS), rsqrtf(s4[2] * (1.0f / 1024.0f) + NORM_EPS), rsqrtf(s4[3] * (1.0f / 1024.0f) + NORM_EPS)}; }
#pragma unroll
        for (int ai = 0; ai < 2; ++ai)
#pragma unroll
            for (int m = 0; m < 4; ++m) { bf16_t* rowp = VT + (size_t)(row0 + ai * HALF + m * 16) * ldv + col0;
#pragma unroll
                for (int bj = 0; bj < 2; ++bj) { const f32x4 v0 = acc[ai][bj][m][0] * rsv[bj][0], v1 = acc[ai][bj][m][1] * rsv[bj][1];
                    u32x4 w; w.x = cvt_pk_bf16(v0[0], v0[1]); w.y = cvt_pk_bf16(v0[2], v0[3]); w.z = cvt_pk_bf16(v1[0], v1[1]); w.w = cvt_pk_bf16(v1[2], v1[3]);
                    *(u32x4*)(rowp + bj * HALF) = w; } }
    }
};
template <class Epi, class Sched, bool ALIGN_EPI = false, bool SP2 = false>
__device__ __forceinline__ void gemm_phase(PG8_LAS unsigned char* lds, const Gemm g, const Sched& S, const Epi& E) {
    int tid_ = threadIdx.x; asm volatile("" : "+v"(tid_));
    const int tid = tid_, wid = __builtin_amdgcn_readfirstlane(tid >> 6), lane = tid & 63, wr = wid >> 2, wc = wid & 3, fr = lane & 15, fq = lane >> 4;
    const int K = g.K, nt = K / BK;
    unsigned voffA[2], voffB[2];
#pragma unroll
    for (int i = 0; i < 2; ++i) { int R, C; stage_rc(tid * 16 + i * 8192, R, C); const int Rb = Epi::PERM ? ((R & ~31) + perm32(R & 31)) : R;
        voffA[i] = (unsigned)(R * K + C) * 2u; voffB[i] = (unsigned)(Rb * K + C) * 2u; }
    const size_t kstep = (size_t)(BK * 2);
    const size_t hstep = (size_t)HALF * K * 2;
    const size_t tstep = 2 * hstep;
    const unsigned ldsw = (unsigned)wid * 1024u;
    const int aoff = lds_byte(wr * 64 + fr, fq * 8), boff = lds_byte(wc * 32 + fr, fq * 8);
#define PG8_SA(b, h) (((b) * 2 + (h)) * HTB)
#define PG8_SB(b, h) ((4 + (b) * 2 + (h)) * HTB)
#define PG8_STAGE(bufoff, gbase, voff) do { _Pragma("unroll") for (int _i = 0; _i < 2; ++_i) \
        __builtin_amdgcn_global_load_lds((const unsigned*)((const char*)(gbase) + (voff)[_i]), (PG8_LAS unsigned*)(lds + (bufoff) + ldsw + _i * 8192), 16, 0, 0); } while (0)
#define PG8_LDA(dst, b, h) do { _Pragma("unroll") for (int m = 0; m < 4; ++m) _Pragma("unroll") for (int k = 0; k < 2; ++k) dst[m][k] = *(const PG8_LAS bf16x8*)(lds + PG8_SA(b, h) + aoff + m * 2048 + k * 1024); } while (0)
#define PG8_LDB(dst, b, h) do { _Pragma("unroll") for (int n = 0; n < 2; ++n) _Pragma("unroll") for (int k = 0; k < 2; ++k) dst[n][k] = *(const PG8_LAS bf16x8*)(lds + PG8_SB(b, h) + boff + n * 2048 + k * 1024); } while (0)
#define PG8_MMA(ai, bj, At, Bt) do { __builtin_amdgcn_s_setprio(1); _Pragma("unroll") for (int m = 0; m < 4; ++m) _Pragma("unroll") for (int n = 0; n < 2; ++n) _Pragma("unroll") for (int k = 0; k < 2; ++k) \
        acc[ai][bj][m][n] = __builtin_amdgcn_mfma_f32_16x16x32_bf16(Bt[n][k], At[m][k], acc[ai][bj][m][n], 0, 0, 0); __builtin_amdgcn_s_setprio(0); } while (0)
#define PG8_WAIT_V(n) asm volatile("s_waitcnt vmcnt(" #n ")" ::: "memory")
#define PG8_WAIT_L(n) asm volatile("s_waitcnt lgkmcnt(" #n ")" ::: "memory")
#define PG8_BAR __builtin_amdgcn_s_barrier()
#define PG8_SCHED __builtin_amdgcn_sched_barrier(0)
    Unit cur, nxt; int ui = 0;
    if (!S.next(0, cur)) return;
    f32x4 acc[2][2][4][2];
#pragma unroll
    for (int a = 0; a < 2; ++a)
#pragma unroll
        for (int b = 0; b < 2; ++b)
#pragma unroll
            for (int m = 0; m < 4; ++m)
#pragma unroll
                for (int n = 0; n < 2; ++n) acc[a][b][m][n] = (f32x4){0.f, 0.f, 0.f, 0.f};
    bf16x8 At[4][2], B0[2][2], B1[2][2];
    const char* cA = (const char*)g.A + (size_t)cur.pm * tstep; const char* cB = (const char*)g.Bt + (size_t)cur.pn * tstep;
    S.a_ready(cur);
    if constexpr (SP2) {
        PG8_STAGE(PG8_SB(0, 0), cB, voffB); PG8_STAGE(PG8_SB(0, 1), cB + hstep, voffB); PG8_STAGE(PG8_SA(0, 0), cA, voffA); PG8_STAGE(PG8_SA(0, 1), cA + hstep, voffA);
        if (wr == 1) PG8_BAR;
        PG8_WAIT_V(2); PG8_BAR;
        PG8_STAGE(PG8_SB(1, 0), cB + kstep, voffB); PG8_STAGE(PG8_SA(1, 0), cA + kstep, voffA); PG8_STAGE(PG8_SB(1, 1), cB + hstep + kstep, voffB);
        PG8_WAIT_V(6); PG8_BAR;
    } else {
        PG8_STAGE(PG8_SB(0, 0), cB, voffB); PG8_STAGE(PG8_SA(0, 0), cA, voffA); PG8_STAGE(PG8_SB(0, 1), cB + hstep, voffB); PG8_STAGE(PG8_SA(0, 1), cA + hstep, voffA);
        if (wr == 1) PG8_BAR;
        PG8_WAIT_V(4); PG8_BAR;
        PG8_STAGE(PG8_SB(1, 0), cB + kstep, voffB); PG8_STAGE(PG8_SA(1, 0), cA + kstep, voffA); PG8_STAGE(PG8_SB(1, 1), cB + hstep + kstep, voffB);
        PG8_WAIT_V(6); PG8_BAR;
    }
    for (;;) {
        const bool has_next = S.next(ui + 1, nxt);
        const char* nA = has_next ? (const char*)g.A + (size_t)nxt.pm * tstep : cA; const char* nB = has_next ? (const char*)g.Bt + (size_t)nxt.pn * tstep : cB;
        for (int t = 0; t < nt; t += 2) {
            const bool last = (t == nt - 2);
            const char* a1 = cA + (size_t)(t + 1) * kstep;
            const char* a2 = last ? nA : cA + (size_t)(t + 2) * kstep; const char* b2 = last ? nB : cB + (size_t)(t + 2) * kstep;
            const char* a3 = a2 + kstep; const char* b3 = b2 + kstep;
            if (last && has_next) S.a_ready(nxt);
            if constexpr (SP2) {
            PG8_LDB(B0, 0, 0); PG8_LDB(B1, 0, 1); PG8_SCHED; PG8_LDA(At, 0, 0); PG8_STAGE(PG8_SA(1, 1), a1 + hstep, voffA);
            PG8_WAIT_V(8); PG8_WAIT_L(0); PG8_BAR; PG8_MMA(0, 0, At, B0); PG8_MMA(0, 1, At, B1); PG8_BAR; PG8_SCHED;
            PG8_LDA(At, 0, 1); PG8_STAGE(PG8_SB(0, 0), b2, voffB); PG8_STAGE(PG8_SB(0, 1), b2 + hstep, voffB); PG8_STAGE(PG8_SA(0, 0), a2, voffA);
            PG8_WAIT_V(8); PG8_WAIT_L(0); PG8_BAR; PG8_MMA(1, 0, At, B0); PG8_MMA(1, 1, At, B1); PG8_BAR; PG8_SCHED;
            PG8_LDB(B0, 1, 0); PG8_LDB(B1, 1, 1); PG8_SCHED; PG8_LDA(At, 1, 0); PG8_STAGE(PG8_SA(0, 1), a2 + hstep, voffA);
            PG8_WAIT_V(8); PG8_WAIT_L(0); PG8_BAR; PG8_MMA(0, 0, At, B0); PG8_MMA(0, 1, At, B1); PG8_BAR; PG8_SCHED;
            PG8_LDA(At, 1, 1); PG8_STAGE(PG8_SB(1, 0), b3, voffB); PG8_STAGE(PG8_SB(1, 1), b3 + hstep, voffB); PG8_STAGE(PG8_SA(1, 0), a3, voffA);
            PG8_WAIT_V(8); PG8_WAIT_L(0); PG8_BAR; PG8_MMA(1, 0, At, B0); PG8_MMA(1, 1, At, B1); PG8_BAR; PG8_SCHED;
            } else {
            PG8_LDB(B0, 0, 0); PG8_SCHED; PG8_LDA(At, 0, 0); PG8_STAGE(PG8_SA(1, 1), a1 + hstep, voffA);
            PG8_WAIT_L(8); PG8_BAR; PG8_WAIT_L(0); PG8_MMA(0, 0, At, B0); PG8_BAR; PG8_SCHED;
            PG8_LDB(B1, 0, 1); PG8_STAGE(PG8_SB(0, 0), b2, voffB);
            PG8_BAR; PG8_WAIT_L(0); PG8_MMA(0, 1, At, B1); PG8_BAR;
            PG8_LDA(At, 0, 1); PG8_STAGE(PG8_SA(0, 0), a2, voffA);
            PG8_BAR; PG8_WAIT_L(0); PG8_MMA(1, 0, At, B0); PG8_BAR; PG8_SCHED;
            PG8_STAGE(PG8_SB(0, 1), b2 + hstep, voffB);
            PG8_WAIT_V(6); PG8_BAR; PG8_MMA(1, 1, At, B1); PG8_BAR;
            PG8_LDB(B0, 1, 0); PG8_SCHED; PG8_LDA(At, 1, 0); PG8_STAGE(PG8_SA(0, 1), a2 + hstep, voffA);
            PG8_WAIT_L(8); PG8_BAR; PG8_WAIT_L(0); PG8_MMA(0, 0, At, B0); PG8_BAR; PG8_SCHED;
            PG8_LDB(B1, 1, 1); PG8_STAGE(PG8_SB(1, 0), b3, voffB);
            PG8_BAR; PG8_WAIT_L(0); PG8_MMA(0, 1, At, B1); PG8_BAR;
            PG8_LDA(At, 1, 1); PG8_STAGE(PG8_SA(1, 0), a3, voffA);
            PG8_BAR; PG8_WAIT_L(0); PG8_MMA(1, 0, At, B0); PG8_BAR; PG8_SCHED;
            PG8_STAGE(PG8_SB(1, 1), b3 + hstep, voffB);
            PG8_WAIT_V(6); PG8_BAR; PG8_MMA(1, 1, At, B1); PG8_BAR;
            }
        }
        if constexpr (ALIGN_EPI) { if (wr == 0) PG8_BAR; }
        if constexpr (!Epi::AFTER_DRAIN) { E(acc, cur, wr, wc, fr, fq); S.done(cur); }
        if (!has_next) break;
#pragma unroll
        for (int a = 0; a < 2; ++a)
#pragma unroll
            for (int b = 0; b < 2; ++b)
#pragma unroll
                for (int m = 0; m < 4; ++m)
#pragma unroll
                    for (int n = 0; n < 2; ++n) acc[a][b][m][n] = (f32x4){0.f, 0.f, 0.f, 0.f};
        cur = nxt; cA = nA; cB = nB; ++ui;
        if constexpr (ALIGN_EPI) { if (wr == 1) PG8_BAR; }
    }
    PG8_WAIT_V(0);
    if constexpr (!ALIGN_EPI) { if (wr == 0) PG8_BAR; }
    PG8_BAR;
    if constexpr (Epi::AFTER_DRAIN) { E.fused(acc, cur, wr, wc, fr, fq, lds, wid, lane); S.done(cur); }
#undef PG8_SA
#undef PG8_SB
#undef PG8_STAGE
#undef PG8_LDA
#undef PG8_LDB
#undef PG8_MMA
#undef PG8_WAIT_V
#undef PG8_WAIT_L
#undef PG8_BAR
#undef PG8_SCHED
}
}

constexpr int DM = 1024, NB = 8, SEQ = 4096, MTOK = NB * SEQ, DFF = 2816, INW = 2304, NLAYER = 2, NHEAD = 8;
constexpr int NGU = 2 * DFF;
constexpr int NWIN = 1792;
constexpr float EPS = 1e-6f;
constexpr size_t MiB = 1u << 20;
constexpr size_t WS_SS = 1 * MiB;
constexpr size_t WS_W = 2 * MiB, W_LAYER = 40 * MiB;
constexpr size_t WO_GU1 = 0, WO_D1 = 11 * MiB, WO_WIN = WO_D1 + 5632 * 1024, WO_WV = WO_WIN + 3584 * 1024, WO_WO = WO_WV + 1 * MiB, WO_GU2 = WO_WO + 2 * MiB, WO_D2 = WO_GU2 + 11 * MiB;
static_assert(WO_D2 + 5632 * 1024 <= W_LAYER, "weights per layer");
constexpr size_t WS_XB = 82 * MiB;
constexpr size_t WS_H = 146 * MiB;
constexpr size_t WS_CU = WS_H, WS_P = WS_CU + 16 * MiB, WS_Q = WS_P + 16 * MiB, WS_K = WS_Q + 32 * MiB, WS_VT = WS_K + 32 * MiB;
constexpr size_t WS_Z = 322 * MiB, WS_END = 386 * MiB;
static_assert(WS_VT + 32 * MiB <= WS_Z && WS_W + 2 * W_LAYER <= WS_XB, "d_ws map");
constexpr int LDS_BYTES = 131072 + 16384;
constexpr int RPB_OFF = 131072;

#define LAS __attribute__((address_space(3)))
typedef unsigned short bf16;
typedef unsigned v4u __attribute__((ext_vector_type(4)));
typedef unsigned v2u __attribute__((ext_vector_type(2)));
typedef float f32x4 __attribute__((ext_vector_type(4)));
typedef short bf16x8 __attribute__((ext_vector_type(8)));
#define LDS_WAIT() asm volatile("s_waitcnt lgkmcnt(0)" ::: "memory")
__device__ __forceinline__ float bf2f(unsigned short v) { return __uint_as_float((unsigned)v << 16); }
__device__ __forceinline__ unsigned pk2(float lo, float hi) { return pg8::cvt_pk_bf16(lo, hi); }
__device__ __forceinline__ float wave_sum(float v) {
#pragma unroll
    for (int o = 1; o < 64; o <<= 1) v += __shfl_xor(v, o);
    return v;
}

__device__ __forceinline__ void tr_item(const float* W, int ldw, int srccol0, const float* g, bf16* Bt, int ldb, int dstrow0, int k0, int koff, LAS float* scr, int lane) {
#pragma unroll 8
    for (int i = 0; i < 32; ++i) { const int kk = 2 * i + (lane >> 5); float v = W[(size_t)(k0 + kk) * ldw + srccol0 + (lane & 31)]; if (g) v *= g[k0 + kk]; scr[kk * 33 + (lane & 31)] = v; }
    LDS_WAIT(); asm volatile("" ::: "memory");
    const int c = lane & 7;
#pragma unroll
    for (int j = 0; j < 4; ++j) { const int n = (lane >> 3) + 8 * j; const LAS float* s = scr + (8 * c) * 33 + n;
        v4u o; o.x = pk2(s[0 * 33], s[1 * 33]); o.y = pk2(s[2 * 33], s[3 * 33]); o.z = pk2(s[4 * 33], s[5 * 33]); o.w = pk2(s[6 * 33], s[7 * 33]);
        *(v4u*)(Bt + (size_t)(dstrow0 + n) * ldb + koff + k0 + 8 * c) = o; }
    LDS_WAIT(); asm volatile("" ::: "memory");
}
__device__ __forceinline__ void fold_item(const float* L, int ldl, int kl0, const float* sc, const float* R, int J, bf16* Bt, int kd0, int n0, int lane) {
    float acc[8];
#pragma unroll
    for (int i = 0; i < 8; ++i) acc[i] = 0.f;
    const float* Lp = L + (size_t)kl0 * ldl;
#pragma unroll 4
    for (int j = 0; j < J; ++j) { float w = R[(size_t)j * 1024 + n0 + lane]; if (sc) w *= sc[j];
#pragma unroll
        for (int i = 0; i < 8; ++i) acc[i] += Lp[i * ldl + j] * w; }
    v4u o; o.x = pk2(acc[0], acc[1]); o.y = pk2(acc[2], acc[3]); o.z = pk2(acc[4], acc[5]); o.w = pk2(acc[6], acc[7]);
    *(v4u*)(Bt + (size_t)(n0 + lane) * 1024 + kd0) = o;
}

struct Args { const float* in[22]; float* out; unsigned char* ws; };
constexpr int I_GU = 16 * 176, I_D = 44 * 32, I_WIN = 16 * 56, I_WV = 16 * 16, I_WO = 8 * 32, I_FOLD = 1024;
constexpr int I_LAYER = 2 * I_GU + 2 * I_D + I_WIN + I_WV + I_WO + I_FOLD;

__device__ __forceinline__ void prologue(const Args& a, LAS unsigned char* lds, int gw, int NGW, int wave, int lane) {
    LAS float* scr = (LAS float*)(lds + wave * 16384);
    unsigned char* ws = a.ws;
    for (int it = gw; it < NLAYER * I_LAYER; it += NGW) {
        const int l = it / I_LAYER; int r = it % I_LAYER;
        unsigned char* wl = ws + WS_W + (size_t)l * W_LAYER;
        if (r < 2 * I_GU) {
            const int f = r / I_GU; r %= I_GU; const int kb = r / 176, nb = r % 176, cc = 32 * nb, pn = cc >> 8, bj = (cc >> 7) & 1, j = cc & 127;
            const float* Wg = a.in[f ? 19 : 2] + (size_t)l * DM * DFF; const float* Wu = a.in[f ? 20 : 3] + (size_t)l * DM * DFF; const float* g = a.in[f ? 18 : 1] + l * DM;
            tr_item(bj ? Wu : Wg, DFF, 128 * pn + j, g, (bf16*)(wl + (f ? WO_GU2 : WO_GU1)), DM, cc, 64 * kb, 0, scr, lane); continue; }
        r -= 2 * I_GU;
        if (r < 2 * I_D) { const int f = r / I_D; r %= I_D; const int kb = r / 32, nb = r % 32;
            tr_item(a.in[f ? 21 : 4] + (size_t)l * DFF * DM, DM, 32 * nb, nullptr, (bf16*)(wl + (f ? WO_D2 : WO_D1)), DFF, 32 * nb, 64 * kb, 0, scr, lane); continue; }
        r -= 2 * I_D;
        if (r < I_WIN) { const int kb = r / 56, nb = r % 56, cc = 32 * nb; int src;
            if (cc < 512) { const int pn = cc >> 8, bj = (cc >> 7) & 1, j = cc & 127; src = (bj ? 256 : 0) + 128 * pn + j; }
            else if (cc < 768) src = cc;
            else { const int t = cc - 768, which = t >> 9, t2 = t & 511, pn2 = t2 >> 8, bj = (t2 >> 7) & 1, wc = (t2 >> 5) & 3; src = 768 + which * 512 + 256 * pn2 + 64 * wc + 32 * bj; }
            tr_item(a.in[6] + (size_t)l * DM * INW, INW, src, a.in[5] + l * DM, (bf16*)(wl + WO_WIN), DM, cc, 64 * kb, 0, scr, lane); continue; }
        r -= I_WIN;
        if (r < I_WV) { const int kb = r / 16, nb = r % 16;
            tr_item(a.in[6] + (size_t)l * DM * INW, INW, 1792 + 32 * nb, a.in[5] + l * DM, (bf16*)(wl + WO_WV), DM, 32 * nb, 64 * kb, 0, scr, lane); continue; }
        r -= I_WV;
        const float* wout = a.in[17] + (size_t)l * DM * DM;
        if (r < I_WO) { const int kb = r / 32, nb = r % 32;
            tr_item(wout + (size_t)512 * DM, DM, 32 * nb, nullptr, (bf16*)(wl + WO_WO), DM, 32 * nb, 64 * kb, 512, scr, lane); continue; }
        r -= I_WO;
        { const int kg = r / 16, nb = r % 16, k0 = 8 * kg;
            if (k0 < 256) fold_item(a.in[11] + (size_t)l * 65536, 256, k0, nullptr, wout, 256, (bf16*)(wl + WO_WO), k0, 64 * nb, lane);
            else { const int gi = (k0 - 256) >> 6, c0 = (k0 - 256) & 63;
                fold_item(a.in[12] + (size_t)l * 16384 + gi * 4096, 64, c0, a.in[13] + l * 256 + 64 * gi, wout + (size_t)(256 + 64 * gi) * DM, 64, (bf16*)(wl + WO_WO), k0, 64 * nb, lane); } }
    }
    const float* x = a.in[0]; bf16* XB = (bf16*)(ws + WS_XB); float* SS = (float*)(ws + WS_SS);
    for (int m = gw; m < MTOK; m += NGW) {
        const f32x4* xr = (const f32x4*)(x + (size_t)m * DM) + lane; f32x4 v[4]; float s = 0.f;
#pragma unroll
        for (int j = 0; j < 4; ++j) { v[j] = xr[64 * j]; s += (v[j].x * v[j].x + v[j].y * v[j].y) + (v[j].z * v[j].z + v[j].w * v[j].w); }
        s = wave_sum(s);
        v2u* o8 = (v2u*)(XB + (size_t)m * DM) + lane;
#pragma unroll
        for (int j = 0; j < 4; ++j) { v2u w; w.x = pk2(v[j].x, v[j].y); w.y = pk2(v[j].z, v[j].w); o8[64 * j] = w; }
        if (lane == 0) SS[m] = s;
    }
    for (int i = gw * 64 + lane; i < 5 * MTOK; i += NGW * 64) SS[MTOK + i] = 0.f;
}

__device__ __forceinline__ void attn_unit(int b, int h, int r, int cb, const bf16* Q, const bf16* K, const bf16* VT, const LAS float* rpbs, bf16* Z, int lane) {
    const int fr = lane & 15, fq = lane >> 4;
    const int r0 = min(max(r - 4, 0), 56), kstart = min(max(16 * cb - 8, 0), 32), qcol = 16 * cb + fr, c0 = min(max(qcol - 8, 0), 48);
    const size_t tokb = (size_t)b * SEQ;
    const bf16* qp = Q + (tokb + r * 64 + qcol) * 512 + h * 64 + 8 * fq;
    const bf16x8 q0 = *(const bf16x8*)qp, q1 = *(const bf16x8*)(qp + 32);
    f32x4 s[8][2];
    const int kk = 8 * (fr >> 2) + (fr & 3);
#pragma unroll
    for (int i = 0; i < 8; ++i)
#pragma unroll
        for (int t = 0; t < 2; ++t) { const bf16* kp = K + (tokb + (r0 + i) * 64 + kstart + kk + 4 * t) * 512 + h * 64 + 8 * fq;
            const bf16x8 k0 = *(const bf16x8*)kp, k1 = *(const bf16x8*)(kp + 32);
            f32x4 c = (f32x4){0.f, 0.f, 0.f, 0.f};
            c = __builtin_amdgcn_mfma_f32_16x16x32_bf16(k0, q0, c, 0, 0, 0); c = __builtin_amdgcn_mfma_f32_16x16x32_bf16(k1, q1, c, 0, 0, 0); s[i][t] = c; }
    int dcc[8]; bool val[8];
#pragma unroll
    for (int j = 0; j < 8; ++j) { const int kc = kstart + 8 * fq + j, dc = kc - qcol + 15; val[j] = (kc >= c0) && (kc < c0 + 16); dcc[j] = min(max(dc, 0), 30); }
    float mx = -3.0e38f;
#pragma unroll
    for (int i = 0; i < 8; ++i) { const LAS float* bp = rpbs + h * 465 + (r0 + i - r + 7) * 31;
#pragma unroll
        for (int t = 0; t < 2; ++t)
#pragma unroll
            for (int e = 0; e < 4; ++e) { const int j = 4 * t + e; const float v = val[j] ? s[i][t][e] + bp[dcc[j]] : -1.0e30f; s[i][t][e] = v; mx = fmaxf(mx, v); } }
    mx = fmaxf(mx, __shfl_xor(mx, 16)); mx = fmaxf(mx, __shfl_xor(mx, 32));
    float l = 0.f; bf16x8 pb[8];
#pragma unroll
    for (int i = 0; i < 8; ++i) { float p[8];
#pragma unroll
        for (int t = 0; t < 2; ++t)
#pragma unroll
            for (int e = 0; e < 4; ++e) { const float pv = __expf(s[i][t][e] - mx); p[4 * t + e] = pv; l += pv; }
        v4u w; w.x = pk2(p[0], p[1]); w.y = pk2(p[2], p[3]); w.z = pk2(p[4], p[5]); w.w = pk2(p[6], p[7]);
        pb[i] = __builtin_bit_cast(bf16x8, w); }
    l += __shfl_xor(l, 16); l += __shfl_xor(l, 32);
    f32x4 o[4];
#pragma unroll
    for (int jd = 0; jd < 4; ++jd) o[jd] = (f32x4){0.f, 0.f, 0.f, 0.f};
#pragma unroll
    for (int i = 0; i < 8; ++i)
#pragma unroll
        for (int jd = 0; jd < 4; ++jd) { const int d = 16 * (fr >> 2) + 4 * jd + (fr & 3);
            const bf16x8 vf = *(const bf16x8*)(VT + (size_t)(h * 64 + d) * MTOK + tokb + (r0 + i) * 64 + kstart + 8 * fq);
            o[jd] = __builtin_amdgcn_mfma_f32_16x16x32_bf16(vf, pb[i], o[jd], 0, 0, 0); }
    const float il = 1.0f / l;
    bf16* zp = Z + (tokb + r * 64 + qcol) * 1024 + 512 + h * 64 + 16 * fq;
    v4u w0, w1;
    w0.x = pk2(o[0][0] * il, o[0][1] * il); w0.y = pk2(o[0][2] * il, o[0][3] * il); w0.z = pk2(o[1][0] * il, o[1][1] * il); w0.w = pk2(o[1][2] * il, o[1][3] * il);
    w1.x = pk2(o[2][0] * il, o[2][1] * il); w1.y = pk2(o[2][2] * il, o[2][3] * il); w1.z = pk2(o[3][0] * il, o[3][1] * il); w1.w = pk2(o[3][2] * il, o[3][3] * il);
    *(v4u*)zp = w0; *(v4u*)(zp + 8) = w1;
}
__device__ __forceinline__ void conv_item(int item, const bf16* CU, const float* dw, const float* dwb, const float* lng, const float* lnb, bf16* Z, LAS float* st, int tid) {
    const int b = item >> 6, t0 = (item & 63) * 64, c = tid & 255, half = tid >> 8, lane = tid & 63, wave = tid >> 6;
    float w[31];
#pragma unroll
    for (int k = 0; k < 31; ++k) w[k] = dw[k * 256 + c];
    const float bias = dwb[c];
    const bf16* cp = CU + (size_t)b * SEQ * 256 + c;
#pragma unroll 1
    for (int ch = 0; ch < 4; ++ch) { const int tb = t0 + half * 32 + ch * 8; float in[38];
#pragma unroll
        for (int j = 0; j < 38; ++j) { const int tt = tb - 15 + j; const int tc = min(max(tt, 0), SEQ - 1); const float v = bf2f(cp[(size_t)tc * 256]); in[j] = (tt == tc) ? v : 0.f; }
#pragma unroll
        for (int o = 0; o < 8; ++o) { float acc = bias;
#pragma unroll
            for (int k = 0; k < 31; ++k) acc += w[k] * in[o + k];
            st[(half * 32 + ch * 8 + o) * 256 + c] = acc; } }
    __syncthreads();
    const f32x4 g4 = *(const f32x4*)(lng + 4 * lane), b4 = *(const f32x4*)(lnb + 4 * lane);
#pragma unroll 2
    for (int tt = 0; tt < 8; ++tt) { const int tok = 8 * wave + tt; const f32x4 v = *(const LAS f32x4*)(st + tok * 256 + 4 * lane);
        const float mean = wave_sum((v.x + v.y) + (v.z + v.w)) * (1.0f / 256.0f); const f32x4 d = v - mean;
        const float var = wave_sum((d.x * d.x + d.y * d.y) + (d.z * d.z + d.w * d.w)) * (1.0f / 256.0f); const float rstd = rsqrtf(var + EPS);
        f32x4 y = d * rstd * g4 + b4;
        y.x *= pg8::fsigmoid(y.x); y.y *= pg8::fsigmoid(y.y); y.z *= pg8::fsigmoid(y.z); y.w *= pg8::fsigmoid(y.w);
        v2u o; o.x = pk2(y.x, y.y); o.y = pk2(y.z, y.w);
        *(v2u*)(Z + ((size_t)b * SEQ + t0 + tok) * 1024 + 4 * lane) = o; }
    __syncthreads();
}
__device__ __forceinline__ float pool_ld(const bf16* pc, int j) { const int jc = min(max(j, 0), SEQ - 1); const float v = bf2f(pc[(size_t)jc * 256]); return (j == jc) ? v : 0.f; }
__device__ __forceinline__ void pool_item(int item, const bf16* P, bf16* Z, int tid) {
    const int b = item >> 6, t0 = (item & 63) * 64, c = tid & 255, half = tid >> 8, g = c >> 6, w = 2 << g, hw = w >> 1, tb = t0 + half * 32;
    const bf16* pc = P + (size_t)b * SEQ * 256 + c;
    float sum = 0.f;
    for (int j = tb - hw; j < tb - hw + w; ++j) sum += pool_ld(pc, j);
#pragma unroll 4
    for (int o = 0; o < 32; ++o) { const int t = tb + o, lo = max(t - hw, 0), hi = min(t - hw + w, SEQ);
        const float pt = bf2f(pc[(size_t)t * 256]);
        const float mixed = sum / (float)(hi - lo) - pt;
        Z[((size_t)b * SEQ + t) * 1024 + 256 + c] = (bf16)(pk2(mixed, 0.f) & 0xffffu);
        sum += pool_ld(pc, t - hw + w) - pool_ld(pc, t - hw); }
}

__global__ void __launch_bounds__(512, 2) fwd_megakernel(Args a) {
    extern __shared__ __attribute__((aligned(16))) unsigned char lds_raw[];
    LAS unsigned char* lds = (LAS unsigned char*)lds_raw;
    cg::grid_group grid = cg::this_grid();
    const int tid = threadIdx.x, lane = tid & 63, wave = __builtin_amdgcn_readfirstlane(tid >> 6);
    const int G = gridDim.x, bid = blockIdx.x;
    const int vcu = (G % 8 == 0) ? (bid % 8) * (G / 8) + bid / 8 : bid;
    unsigned char* ws = a.ws;
    float* SS = (float*)(ws + WS_SS); bf16* XB = (bf16*)(ws + WS_XB); bf16* H = (bf16*)(ws + WS_H); bf16* Z = (bf16*)(ws + WS_Z);
    bf16 *CU = (bf16*)(ws + WS_CU), *P = (bf16*)(ws + WS_P), *Qb = (bf16*)(ws + WS_Q), *Kb = (bf16*)(ws + WS_K), *VT = (bf16*)(ws + WS_VT);

    prologue(a, lds, vcu * 8 + wave, G * 8, wave, lane);
    grid.sync();

#pragma unroll 1
    for (int step = 0; step < 2 * NLAYER; ++step) {
        const int l = step >> 1, f = step & 1;
        unsigned char* wl = ws + WS_W + (size_t)l * W_LAYER;
        if (f == 1) {
            const float* ssm = SS + (size_t)(3 * l + 1) * MTOK;
            { pg8::Gemm g{XB, (const bf16*)(wl + WO_WIN), MTOK, NWIN, DM}; pg8::StaticOrder S; S.init(MTOK, NWIN, G, bid);
              pg8::EpiWin E{CU, P, Qb, Kb, ssm, a.in[14] + l * 64, a.in[15] + l * 64};
              pg8::gemm_phase<pg8::EpiWin, pg8::StaticOrder, true, true>(lds, g, S, E); }
            { pg8::Gemm g{(const bf16*)(wl + WO_WV), XB, 512, MTOK, DM}; pg8::StaticOrder S; S.init(512, MTOK, G, bid);
              pg8::EpiVT E{VT, ssm, MTOK};
              pg8::gemm_phase<pg8::EpiVT, pg8::StaticOrder, true, true>(lds, g, S, E); }
            grid.sync();
            {
                int mt_ = threadIdx.x; asm volatile("" : "+v"(mt_));
                const int tid = mt_, lane = tid & 63, wave = __builtin_amdgcn_readfirstlane(tid >> 6);
                LAS float* rpbs = (LAS float*)(lds + RPB_OFF);
                const float* rpb = a.in[16] + (size_t)l * 3720;
                for (int i = tid; i < 3720; i += 512) rpbs[i] = rpb[i];
                __syncthreads();
                const int a0 = (int)((long)vcu * 2048 / G), a1 = (int)((long)(vcu + 1) * 2048 / G);
                for (int it = a0; it < a1; ++it) { const int bh = it >> 5, rp = it & 31;
                    attn_unit(bh >> 3, bh & 7, 2 * rp + (wave >> 2), wave & 3, Qb, Kb, VT, rpbs, Z, lane); }
                __syncthreads();
                const int c0i = (int)((long)vcu * 512 / G), c1i = (int)((long)(vcu + 1) * 512 / G);
                for (int it = c0i; it < c1i; ++it)
                    conv_item(it, CU, a.in[7] + (size_t)l * 31 * 256, a.in[8] + l * 256, a.in[9] + l * 256, a.in[10] + l * 256, Z, (LAS float*)lds, tid);
                for (int it = c0i; it < c1i; ++it) pool_item(it, P, Z, tid);
                __syncthreads();
            }
            grid.sync();
            { pg8::Gemm g{Z, (const bf16*)(wl + WO_WO), MTOK, DM, DM}; pg8::StaticOrder S; S.init(MTOK, DM, G, bid);
              pg8::EpiResid E{a.out, a.out, XB, SS + (size_t)(3 * l + 2) * MTOK, 1.0f};
              pg8::gemm_phase<pg8::EpiResid, pg8::StaticOrder, true, true>(lds, g, S, E); }
            grid.sync();
        }
        { pg8::Gemm g{XB, (const bf16*)(wl + (f ? WO_GU2 : WO_GU1)), MTOK, NGU, DM}; pg8::StaticOrder S; S.init(MTOK, NGU, G, bid);
          pg8::EpiSwiglu E{H, DFF, SS + (size_t)(3 * l + (f ? 2 : 0)) * MTOK};
          pg8::gemm_phase<pg8::EpiSwiglu, pg8::StaticOrder, true, true>(lds, g, S, E); }
        grid.sync();
        { pg8::Gemm g{H, (const bf16*)(wl + (f ? WO_D2 : WO_D1)), MTOK, DM, DFF}; pg8::StaticOrder S; S.init(MTOK, DM, G, bid);
          const bool last = (step == 2 * NLAYER - 1);
          pg8::EpiResid E{step == 0 ? a.in[0] : a.out, a.out, XB, last ? nullptr : SS + (size_t)(f ? 3 * (l + 1) : 3 * l + 1) * MTOK, 0.5f};
          pg8::gemm_phase<pg8::EpiResid, pg8::StaticOrder, true, true>(lds, g, S, E); }
        if (step != 2 * NLAYER - 1) grid.sync();
    }
}

extern "C" void kernel_launch(void* const* d_in, const int* in_sizes, int n_in, void* d_out, int out_size, void* d_ws, size_t ws_size, hipStream_t stream) {
    static int grid = 0;
    if (grid == 0) {
        if (n_in != 22 || in_sizes[0] != MTOK * DM || out_size != MTOK * DM || ws_size < WS_END) { fprintf(stderr, "kernel_launch: unexpected shapes (n_in %d, in0 %d, out %d, ws %zu); nothing launched\n", n_in, n_in > 0 ? in_sizes[0] : -1, out_size, ws_size); grid = -1; return; }
        int dev = 0, cus = 0, per_cu = 0;
        if (hipGetDevice(&dev) != hipSuccess || hipDeviceGetAttribute(&cus, hipDeviceAttributeMultiprocessorCount, dev) != hipSuccess) { grid = -1; return; }
        if (hipFuncSetAttribute((const void*)fwd_megakernel, hipFuncAttributeMaxDynamicSharedMemorySize, LDS_BYTES) != hipSuccess) { fprintf(stderr, "kernel_launch: hipFuncSetAttribute failed\n"); grid = -1; return; }
        if (hipOccupancyMaxActiveBlocksPerMultiprocessor(&per_cu, (const void*)fwd_megakernel, 512, LDS_BYTES) != hipSuccess || per_cu < 1) { fprintf(stderr, "kernel_launch: occupancy query gave %d\n", per_cu); (void)hipGetLastError(); per_cu = 1; }
        grid = cus * 1;
    }
    if (grid < 0) return;
    Args a{};
    for (int i = 0; i < 22; ++i) a.in[i] = (const float*)d_in[i];
    a.out = (float*)d_out; a.ws = (unsigned char*)d_ws;
    void* args[] = {&a};
    hipError_t e = hipLaunchCooperativeKernel((const void*)fwd_megakernel, dim3(grid), dim3(512), args, LDS_BYTES, stream);
    if (e != hipSuccess) fprintf(stderr, "kernel_launch: cooperative launch failed: %s (grid %d)\n", hipGetErrorString(e), grid);
}
```

```cpp
#include <hip/hip_runtime.h>
#include <hip/hip_cooperative_groups.h>
#include <cstdio>
#include <cstdint>
namespace cg = cooperative_groups;
namespace pg8 {
#define PG8_LAS __attribute__((address_space(3)))
typedef unsigned short bf16_t;
typedef short bf16x8 __attribute__((ext_vector_type(8)));
typedef float f32x4 __attribute__((ext_vector_type(4)));
typedef unsigned u32x4 __attribute__((ext_vector_type(4)));
constexpr int BM = 256, BK = 64, HALF = 128, HTB = HALF * BK * 2  , STAGE_BYTES = 8 * HTB, NXCD = 8, WGM = 8;

__host__ __device__ __forceinline__ int lds_byte(int r, int c) { const int st = (r >> 4) * 2 + (c >> 5), rr = r & 15, cc = c & 31, ob = rr * 64 + cc * 2; return st * 1024 + (ob ^ (((ob >> 9) & 1) << 5)); }
__host__ __device__ __forceinline__ void stage_rc(int b, int& R, int& C) { const int st = b / 1024, sb = b % 1024, swz = sb ^ (((sb >> 9) & 1) << 5); R = (st >> 1) * 16 + swz / 64; C = (st & 1) * 32 + (swz % 64) / 2; }
__host__ __device__ __forceinline__ int perm32(int rho) { const int n = rho >> 4, i = rho & 15; return 8 * (i >> 2) + 4 * n + (i & 3); }

struct Unit { int pm, pn; };
struct Gemm { const bf16_t* A; const bf16_t* Bt; int M, N, K; };

struct StaticOrder {
    int nM, nN, nwg, G, c;
    __host__ __device__ void init(int M, int N, int G_, int c_) { nM = M / BM; nN = N / BM; nwg = nM * nN; G = G_; c = c_; }
    __host__ __device__ bool next(int i, Unit& u) const {
        const long L = (long)i * G + c; if (L >= nwg) return false;
        int wgid = (int)L; { const int q = nwg / NXCD, r = nwg % NXCD, xcd = wgid % NXCD, off = wgid / NXCD; wgid = (xcd < r ? xcd * (q + 1) : r * (q + 1) + (xcd - r) * q) + off; }
        const int nig = WGM * nN, gid = wgid / nig, fm = gid * WGM, gsz = (nM - fm) < WGM ? (nM - fm) : WGM;
        u.pm = fm + ((wgid % nig) % gsz); u.pn = (wgid % nig) / gsz; return true;
    }
    __device__ __forceinline__ void a_ready(const Unit&) const {}
    __device__ __forceinline__ void done(const Unit&) const {}
};

__device__ __forceinline__ unsigned cvt_pk_bf16(float lo, float hi) { unsigned r; asm volatile("v_cvt_pk_bf16_f32 %0, %1, %2" : "=v"(r) : "v"(lo), "v"(hi)); return r; }
typedef float f32x2 __attribute__((ext_vector_type(2)));
constexpr float NORM_EPS = 1e-6f;
__device__ __forceinline__ float fsigmoid(float x) { return __builtin_amdgcn_rcpf(1.0f + __expf(-x)); }
__device__ __forceinline__ float row_rstd(const float* ss, int row) { return rsqrtf(ss[row] * (1.0f / 1024.0f) + NORM_EPS); }

struct EpiSwiglu {
    static constexpr bool PERM = true, AFTER_DRAIN = false;
    bf16_t* H; int ldh; const float* ss;
    __device__ __forceinline__ void operator()(const f32x4 (&acc)[2][2][4][2], const Unit& u, int wr, int wc, int fr, int fq) const {
        const int row0 = u.pm * BM + wr * 64 + fr, col0 = u.pn * HALF + wc * 32 + 8 * fq;
#pragma unroll
        for (int ai = 0; ai < 2; ++ai)
#pragma unroll
            for (int m = 0; m < 4; ++m) { const int row = row0 + ai * HALF + m * 16; const float rs = row_rstd(ss, row);
                float h[8];
#pragma unroll
                for (int n = 0; n < 2; ++n)
#pragma unroll
                    for (int e = 0; e < 4; ++e) { const float g = acc[ai][0][m][n][e] * rs, up = acc[ai][1][m][n][e] * rs; h[4 * n + e] = g * fsigmoid(g) * up; }
                u32x4 w; w.x = cvt_pk_bf16(h[0], h[1]); w.y = cvt_pk_bf16(h[2], h[3]); w.z = cvt_pk_bf16(h[4], h[5]); w.w = cvt_pk_bf16(h[6], h[7]);
                *(u32x4*)(H + (size_t)row * ldh + col0) = w; }
    }
};
struct EpiResid {
    static constexpr bool PERM = true, AFTER_DRAIN = false;
    const float* base; float* out; bf16_t* xb; float* ssn; float alpha;
    __device__ __forceinline__ void operator()(const f32x4 (&acc)[2][2][4][2], const Unit& u, int wr, int wc, int fr, int fq) const {
        const int row0 = u.pm * BM + wr * 64 + fr, col0 = u.pn * BM + wc * 32 + 8 * fq;
#pragma unroll
        for (int ai = 0; ai < 2; ++ai)
#pragma unroll
            for (int m = 0; m < 4; ++m) { const int row = row0 + ai * HALF + m * 16; float part = 0.f;
#pragma unroll
                for (int bj = 0; bj < 2; ++bj) { const size_t off = (size_t)row * 1024 + col0 + bj * HALF;
                    const f32x4 b0 = *(const f32x4*)(base + off), b1 = *(const f32x4*)(base + off + 4);
                    const f32x4 o0 = b0 + acc[ai][bj][m][0] * alpha, o1 = b1 + acc[ai][bj][m][1] * alpha;
                    *(f32x4*)(out + off) = o0; *(f32x4*)(out + off + 4) = o1;
                    if (ssn) { u32x4 w; w.x = cvt_pk_bf16(o0[0], o0[1]); w.y = cvt_pk_bf16(o0[2], o0[3]); w.z = cvt_pk_bf16(o1[0], o1[1]); w.w = cvt_pk_bf16(o1[2], o1[3]);
                        *(u32x4*)(xb + off) = w;
                        part += (o0[0] * o0[0] + o0[1] * o0[1]) + (o0[2] * o0[2] + o0[3] * o0[3]) + (o1[0] * o1[0] + o1[1] * o1[1]) + (o1[2] * o1[2] + o1[3] * o1[3]); } }
                if (ssn) { part += __shfl_xor(part, 16); part += __shfl_xor(part, 32); if (fq == 0) unsafeAtomicAdd(ssn + row, part); } }
    }
};
struct EpiWin {
    static constexpr bool PERM = true, AFTER_DRAIN = false;
    bf16_t *CU, *P, *Q, *Kq; const float* ss; const float *qg, *kg;
    __device__ __forceinline__ void operator()(const f32x4 (&acc)[2][2][4][2], const Unit& u, int wr, int wc, int fr, int fq) const {
        const int row0 = u.pm * BM + wr * 64 + fr, pn = u.pn;
        if (pn < 2) {
#pragma unroll
            for (int ai = 0; ai < 2; ++ai)
#pragma unroll
                for (int m = 0; m < 4; ++m) { const int row = row0 + ai * HALF + m * 16; const float rs = row_rstd(ss, row); float h[8];
#pragma unroll
                    for (int n = 0; n < 2; ++n)
#pragma unroll
                        for (int e = 0; e < 4; ++e) { const float a = acc[ai][0][m][n][e] * rs, g = acc[ai][1][m][n][e] * rs; h[4 * n + e] = a * fsigmoid(g); }
                    u32x4 w; w.x = cvt_pk_bf16(h[0], h[1]); w.y = cvt_pk_bf16(h[2], h[3]); w.z = cvt_pk_bf16(h[4], h[5]); w.w = cvt_pk_bf16(h[6], h[7]);
                    *(u32x4*)(CU + (size_t)row * 256 + pn * HALF + wc * 32 + 8 * fq) = w; }
        } else if (pn == 2) {
#pragma unroll
            for (int ai = 0; ai < 2; ++ai)
#pragma unroll
                for (int m = 0; m < 4; ++m) { const int row = row0 + ai * HALF + m * 16; const float rs = row_rstd(ss, row);
#pragma unroll
                    for (int bj = 0; bj < 2; ++bj) { const f32x4 v0 = acc[ai][bj][m][0] * rs, v1 = acc[ai][bj][m][1] * rs;
                        u32x4 w; w.x = cvt_pk_bf16(v0[0], v0[1]); w.y = cvt_pk_bf16(v0[2], v0[3]); w.z = cvt_pk_bf16(v1[0], v1[1]); w.w = cvt_pk_bf16(v1[2], v1[3]);
                        *(u32x4*)(P + (size_t)row * 256 + bj * HALF + wc * 32 + 8 * fq) = w; } }
        } else {
            const int which = (pn - 3) >> 1, head = 4 * ((pn - 3) & 1) + wc;
            const float* gp = (which ? kg : qg) + 8 * fq; const float post = which ? 1.0f : 0.125f;
            f32x4 gv[2][2];
#pragma unroll
            for (int bj = 0; bj < 2; ++bj)
#pragma unroll
                for (int n = 0; n < 2; ++n) gv[bj][n] = *(const f32x4*)(gp + 32 * bj + 4 * n) * post;
            bf16_t* dst = (which ? Kq : Q) + head * 64 + 8 * fq;
#pragma unroll
            for (int ai = 0; ai < 2; ++ai)
#pragma unroll
                for (int m = 0; m < 4; ++m) { const int row = row0 + ai * HALF + m * 16; const float rs = row_rstd(ss, row);
                    f32x4 v[2][2]; float q = 0.f;
#pragma unroll
                    for (int bj = 0; bj < 2; ++bj)
#pragma unroll
                        for (int n = 0; n < 2; ++n) { v[bj][n] = acc[ai][bj][m][n] * rs; const f32x4 x = v[bj][n]; q += (x[0] * x[0] + x[1] * x[1]) + (x[2] * x[2] + x[3] * x[3]); }
                    q += __shfl_xor(q, 16); q += __shfl_xor(q, 32);
                    const float r2 = rsqrtf(q * (1.0f / 64.0f) + NORM_EPS);
#pragma unroll
                    for (int bj = 0; bj < 2; ++bj) { const f32x4 v0 = v[bj][0] * gv[bj][0] * r2, v1 = v[bj][1] * gv[bj][1] * r2;
                        u32x4 w; w.x = cvt_pk_bf16(v0[0], v0[1]); w.y = cvt_pk_bf16(v0[2], v0[3]); w.z = cvt_pk_bf16(v1[0], v1[1]); w.w = cvt_pk_bf16(v1[2], v1[3]);
                        *(u32x4*)(dst + (size_t)row * 512 + 32 * bj) = w; } }
        }
    }
};
struct EpiVT {
    static constexpr bool PERM = true, AFTER_DRAIN = false;
    bf16_t* VT; const float* ss; int ldv;
    __device__ __forceinline__ void operator()(const f32x4 (&acc)[2][2][4][2], const Unit& u, int wr, int wc, int fr, int fq) const {
        const int row0 = u.pm * BM + wr * 64 + fr, col0 = u.pn * BM + wc * 32 + 8 * fq;
        f32x4 rsv[2][2];
#pragma unroll
        for (int bj = 0; bj < 2; ++bj)
#pragma unroll
            for (int n = 0; n < 2; ++n) { const f32x4 s4 = *(const f32x4*)(ss + col0 + bj * HALF + 4 * n);
                rsv[bj][n] = (f32x4){rsqrtf(s4[0] * (1.0f / 1024.0f) + NORM_EPS), rsqrtf(s4[1] * (1.0f / 1024.0f) + NORM_EPS), rsqrtf(s4[2] * (1.0f / 1024.0f) + NORM_EPS), rsqrtf(s4[3] * (1.0f / 1024.0f) + NORM_EPS)}; }
#pragma unroll
        for (int ai = 0; ai < 2; ++ai)
#pragma unroll
            for (int m = 0; m < 4; ++m) { bf16_t* rowp = VT + (size_t)(row0 + ai * HALF + m * 16) * ldv + col0;
#pragma unroll
                for (int bj = 0; bj < 2; ++bj) { const f32x4 v0 = acc[ai][bj][m][0] * rsv[bj][0], v1 = acc[ai][bj][m][1] * rsv[bj][1];
                    u32x4 w; w.x = cvt_pk_bf16(v0[0], v0[1]); w.y = cvt_pk_bf16(v0[2], v0[3]); w.z = cvt_pk_bf16(v1[0], v1[1]); w.w = cvt_pk_bf16(v1[2], v1[3]);
                    *(u32x4*)(rowp + bj * HALF) = w; } }
    }
};
template <class Epi, class Sched, bool ALIGN_EPI = false, bool SP2 = false>
__device__ __forceinline__ void gemm_phase(PG8_LAS unsigned char* lds, const Gemm g, const Sched& S, const Epi& E) {
    int tid_ = threadIdx.x; asm volatile("" : "+v"(tid_));
    const int tid = tid_, wid = __builtin_amdgcn_readfirstlane(tid >> 6), lane = tid & 63, wr = wid >> 2, wc = wid & 3, fr = lane & 15, fq = lane >> 4;
    const int K = g.K, nt = K / BK;
    unsigned voffA[2], voffB[2];
#pragma unroll
    for (int i = 0; i < 2; ++i) { int R, C; stage_rc(tid * 16 + i * 8192, R, C); const int Rb = Epi::PERM ? ((R & ~31) + perm32(R & 31)) : R;
        voffA[i] = (unsigned)(R * K + C) * 2u; voffB[i] = (unsigned)(Rb * K + C) * 2u; }
    const size_t kstep = (size_t)(BK * 2);
    const size_t hstep = (size_t)HALF * K * 2;
    const size_t tstep = 2 * hstep;
    const unsigned ldsw = (unsigned)wid * 1024u;
    const int aoff = lds_byte(wr * 64 + fr, fq * 8), boff = lds_byte(wc * 32 + fr, fq * 8);
#define PG8_SA(b, h) (((b) * 2 + (h)) * HTB)
#define PG8_SB(b, h) ((4 + (b) * 2 + (h)) * HTB)
#define PG8_STAGE(bufoff, gbase, voff) do { _Pragma("unroll") for (int _i = 0; _i < 2; ++_i) \
        __builtin_amdgcn_global_load_lds((const unsigned*)((const char*)(gbase) + (voff)[_i]), (PG8_LAS unsigned*)(lds + (bufoff) + ldsw + _i * 8192), 16, 0, 0); } while (0)
#define PG8_LDA(dst, b, h) do { _Pragma("unroll") for (int m = 0; m < 4; ++m) _Pragma("unroll") for (int k = 0; k < 2; ++k) dst[m][k] = *(const PG8_LAS bf16x8*)(lds + PG8_SA(b, h) + aoff + m * 2048 + k * 1024); } while (0)
#define PG8_LDB(dst, b, h) do { _Pragma("unroll") for (int n = 0; n < 2; ++n) _Pragma("unroll") for (int k = 0; k < 2; ++k) dst[n][k] = *(const PG8_LAS bf16x8*)(lds + PG8_SB(b, h) + boff + n * 2048 + k * 1024); } while (0)
#define PG8_MMA(ai, bj, At, Bt) do { __builtin_amdgcn_s_setprio(1); _Pragma("unroll") for (int m = 0; m < 4; ++m) _Pragma("unroll") for (int n = 0; n < 2; ++n) _Pragma("unroll") for (int k = 0; k < 2; ++k) \
        acc[ai][bj][m][n] = __builtin_amdgcn_mfma_f32_16x16x32_bf16(Bt[n][k], At[m][k], acc[ai][bj][m][n], 0, 0, 0); __builtin_amdgcn_s_setprio(0); } while (0)
#define PG8_WAIT_V(n) asm volatile("s_waitcnt vmcnt(" #n ")" ::: "memory")
#define PG8_WAIT_L(n) asm volatile("s_waitcnt lgkmcnt(" #n ")" ::: "memory")
#define PG8_BAR __builtin_amdgcn_s_barrier()
#define PG8_SCHED __builtin_amdgcn_sched_barrier(0)
    Unit cur, nxt; int ui = 0;
    if (!S.next(0, cur)) return;
    f32x4 acc[2][2][4][2];
#pragma unroll
    for (int a = 0; a < 2; ++a)
#pragma unroll
        for (int b = 0; b < 2; ++b)
#pragma unroll
            for (int m = 0; m < 4; ++m)
#pragma unroll
                for (int n = 0; n < 2; ++n) acc[a][b][m][n] = (f32x4){0.f, 0.f, 0.f, 0.f};
    bf16x8 At[4][2], B0[2][2], B1[2][2];
    const char* cA = (const char*)g.A + (size_t)cur.pm * tstep; const char* cB = (const char*)g.Bt + (size_t)cur.pn * tstep;
    S.a_ready(cur);
    if constexpr (SP2) {
        PG8_STAGE(PG8_SB(0, 0), cB, voffB); PG8_STAGE(PG8_SB(0, 1), cB + hstep, voffB); PG8_STAGE(PG8_SA(0, 0), cA, voffA); PG8_STAGE(PG8_SA(0, 1), cA + hstep, voffA);
        if (wr == 1) PG8_BAR;
        PG8_WAIT_V(2); PG8_BAR;
        PG8_STAGE(PG8_SB(1, 0), cB + kstep, voffB); PG8_STAGE(PG8_SA(1, 0), cA + kstep, voffA); PG8_STAGE(PG8_SB(1, 1), cB + hstep + kstep, voffB);
        PG8_WAIT_V(6); PG8_BAR;
    } else {
        PG8_STAGE(PG8_SB(0, 0), cB, voffB); PG8_STAGE(PG8_SA(0, 0), cA, voffA); PG8_STAGE(PG8_SB(0, 1), cB + hstep, voffB); PG8_STAGE(PG8_SA(0, 1), cA + hstep, voffA);
        if (wr == 1) PG8_BAR;
        PG8_WAIT_V(4); PG8_BAR;
        PG8_STAGE(PG8_SB(1, 0), cB + kstep, voffB); PG8_STAGE(PG8_SA(1, 0), cA + kstep, voffA); PG8_STAGE(PG8_SB(1, 1), cB + hstep + kstep, voffB);
        PG8_WAIT_V(6); PG8_BAR;
    }
    for (;;) {
        const bool has_next = S.next(ui + 1, nxt);
        const char* nA = has_next ? (const char*)g.A + (size_t)nxt.pm * tstep : cA; const char* nB = has_next ? (const char*)g.Bt + (size_t)nxt.pn * tstep : cB;
        for (int t = 0; t < nt; t += 2) {
            const bool last = (t == nt - 2);
            const char* a1 = cA + (size_t)(t + 1) * kstep;
            const char* a2 = last ? nA : cA + (size_t)(t + 2) * kstep; const char* b2 = last ? nB : cB + (size_t)(t + 2) * kstep;
            const char* a3 = a2 + kstep; const char* b3 = b2 + kstep;
            if (last && has_next) S.a_ready(nxt);
            if constexpr (SP2) {
            PG8_LDB(B0, 0, 0); PG8_LDB(B1, 0, 1); PG8_SCHED; PG8_LDA(At, 0, 0); PG8_STAGE(PG8_SA(1, 1), a1 + hstep, voffA);
            PG8_WAIT_V(8); PG8_WAIT_L(0); PG8_BAR; PG8_MMA(0, 0, At, B0); PG8_MMA(0, 1, At, B1); PG8_BAR; PG8_SCHED;
            PG8_LDA(At, 0, 1); PG8_STAGE(PG8_SB(0, 0), b2, voffB); PG8_STAGE(PG8_SB(0, 1), b2 + hstep, voffB); PG8_STAGE(PG8_SA(0, 0), a2, voffA);
            PG8_WAIT_V(8); PG8_WAIT_L(0); PG8_BAR; PG8_MMA(1, 0, At, B0); PG8_MMA(1, 1, At, B1); PG8_BAR; PG8_SCHED;
            PG8_LDB(B0, 1, 0); PG8_LDB(B1, 1, 1); PG8_SCHED; PG8_LDA(At, 1, 0); PG8_STAGE(PG8_SA(0, 1), a2 + hstep, voffA);
            PG8_WAIT_V(8); PG8_WAIT_L(0); PG8_BAR; PG8_MMA(0, 0, At, B0); PG8_MMA(0, 1, At, B1); PG8_BAR; PG8_SCHED;
            PG8_LDA(At, 1, 1); PG8_STAGE(PG8_SB(1, 0), b3, voffB); PG8_STAGE(PG8_SB(1, 1), b3 + hstep, voffB); PG8_STAGE(PG8_SA(1, 0), a3, voffA);
            PG8_WAIT_V(8); PG8_WAIT_L(0); PG8_BAR; PG8_MMA(1, 0, At, B0); PG8_MMA(1, 1, At, B1); PG8_BAR; PG8_SCHED;
            } else {
            PG8_LDB(B0, 0, 0); PG8_SCHED; PG8_LDA(At, 0, 0); PG8_STAGE(PG8_SA(1, 1), a1 + hstep, voffA);
            PG8_WAIT_L(8); PG8_BAR; PG8_WAIT_L(0); PG8_MMA(0, 0, At, B0); PG8_BAR; PG8_SCHED;
            PG8_LDB(B1, 0, 1); PG8_STAGE(PG8_SB(0, 0), b2, voffB);
            PG8_BAR; PG8_WAIT_L(0); PG8_MMA(0, 1, At, B1); PG8_BAR;
            PG8_LDA(At, 0, 1); PG8_STAGE(PG8_SA(0, 0), a2, voffA);
            PG8_BAR; PG8_WAIT_L(0); PG8_MMA(1, 0, At, B0); PG8_BAR; PG8_SCHED;
            PG8_STAGE(PG8_SB(0, 1), b2 + hstep, voffB);
            PG8_WAIT_V(6); PG8_BAR; PG8_MMA(1, 1, At, B1); PG8_BAR;
            PG8_LDB(B0, 1, 0); PG8_SCHED; PG8_LDA(At, 1, 0); PG8_STAGE(PG8_SA(0, 1), a2 + hstep, voffA);
            PG8_WAIT_L(8); PG8_BAR; PG8_WAIT_L(0); PG8_MMA(0, 0, At, B0); PG8_BAR; PG8_SCHED;
            PG8_LDB(B1, 1, 1); PG8_STAGE(PG8_SB(1, 0), b3, voffB);
            PG8_BAR; PG8_WAIT_L(0); PG8_MMA(0, 1, At, B1); PG8_BAR;
            PG8_LDA(At, 1, 1); PG8_STAGE(PG8_SA(1, 0), a3, voffA);
            PG8_BAR; PG8_WAIT_L(0); PG8_MMA(1, 0, At, B0); PG8_BAR; PG8_SCHED;
            PG8_STAGE(PG8_SB(1, 1), b3 + hstep, voffB);
            PG8_WAIT_V(6); PG8_BAR; PG8_MMA(1, 1, At, B1); PG8_BAR;
            }
        }
        if constexpr (ALIGN_EPI) { if (wr == 0) PG8_BAR; }
        if constexpr (!Epi::AFTER_DRAIN) { E(acc, cur, wr, wc, fr, fq); S.done(cur); }
        if (!has_next) break;
#pragma unroll
        for (int a = 0; a < 2; ++a)
#pragma unroll
            for (int b = 0; b < 2; ++b)
#pragma unroll
                for (int m = 0; m < 4; ++m)
#pragma unroll
                    for (int n = 0; n < 2; ++n) acc[a][b][m][n] = (f32x4){0.f, 0.f, 0.f, 0.f};
        cur = nxt; cA = nA; cB = nB; ++ui;
        if constexpr (ALIGN_EPI) { if (wr == 1) PG8_BAR; }
    }
    PG8_WAIT_V(0);
    if constexpr (!ALIGN_EPI) { if (wr == 0) PG8_BAR; }
    PG8_BAR;
    if constexpr (Epi::AFTER_DRAIN) { E.fused(acc, cur, wr, wc, fr, fq, lds, wid, lane); S.done(cur); }
#undef PG8_SA
#undef PG8_SB
#undef PG8_STAGE
#undef PG8_LDA
#undef PG8_LDB
#undef PG8_MMA
#undef PG8_WAIT_V
#undef PG8_WAIT_L
#undef PG8_BAR
#undef PG8_SCHED
}
}

constexpr int DM = 1024, NB = 8, SEQ = 4096, MTOK = NB * SEQ, DFF = 2816, INW = 2304, NLAYER = 2, NHEAD = 8;
constexpr int NGU = 2 * DFF;
constexpr int NWIN = 1792;
constexpr float EPS = 1e-6f;
constexpr size_t MiB = 1u << 20;
constexpr size_t WS_CTL = 0, CTL_ZERO_BYTES = 65536; constexpr int CW_BAR = 4096;
constexpr size_t WS_SS = 1 * MiB;
constexpr size_t WS_W = 2 * MiB, W_LAYER = 40 * MiB;
constexpr size_t WO_GU1 = 0, WO_D1 = 11 * MiB, WO_WIN = WO_D1 + 5632 * 1024, WO_WV = WO_WIN + 3584 * 1024, WO_WO = WO_WV + 1 * MiB, WO_GU2 = WO_WO + 2 * MiB, WO_D2 = WO_GU2 + 11 * MiB;
static_assert(WO_D2 + 5632 * 1024 <= W_LAYER, "weights per layer");
constexpr size_t WS_XB = 82 * MiB;
constexpr size_t WS_H = 146 * MiB;
constexpr size_t WS_CU = WS_H, WS_P = WS_CU + 16 * MiB, WS_Q = WS_P + 16 * MiB, WS_K = WS_Q + 32 * MiB, WS_VT = WS_K + 32 * MiB;
constexpr size_t WS_Z = 322 * MiB, WS_END = 386 * MiB;
static_assert(WS_VT + 32 * MiB <= WS_Z && WS_W + 2 * W_LAYER <= WS_XB, "d_ws map");
constexpr int LDS_BYTES = 131072 + 16384;
constexpr int RPB_OFF = 131072, MISC_OFF = 131072 + 15360;

#define LAS __attribute__((address_space(3)))
typedef unsigned short bf16;
typedef unsigned v4u __attribute__((ext_vector_type(4)));
typedef unsigned v2u __attribute__((ext_vector_type(2)));
typedef float f32x4 __attribute__((ext_vector_type(4)));
typedef short bf16x8 __attribute__((ext_vector_type(8)));
#define LDS_WAIT() asm volatile("s_waitcnt lgkmcnt(0)" ::: "memory")
__device__ __forceinline__ float bf2f(unsigned short v) { return __uint_as_float((unsigned)v << 16); }
__device__ __forceinline__ unsigned pk2(float lo, float hi) { return pg8::cvt_pk_bf16(lo, hi); }
__device__ __forceinline__ float wave_sum(float v) {
#pragma unroll
    for (int o = 1; o < 64; o <<= 1) v += __shfl_xor(v, o);
    return v;
}

typedef __attribute__((address_space(1))) unsigned gu32;
#define RLX_AGENT __ATOMIC_RELAXED, __HIP_MEMORY_SCOPE_AGENT
#define XB_TMO      128
#define XB_XCNT(j)  (256  + 64 * (j))
#define XB_XSUB(j)  (1280 + 64 * (j))
#define XB_XGEN(j)  (2304 + 64 * (j))
#define XB_TOP      3328
#define XB_TOPGEN   3392
#define XCD_BAR_WORDS 3456
#define XB_SPIN_CAP (1u << 18)

__device__ __forceinline__ unsigned xb_ld(unsigned* p)              { return __hip_atomic_load(p, __ATOMIC_RELAXED, __HIP_MEMORY_SCOPE_AGENT); }
__device__ __forceinline__ unsigned xb_add(unsigned* p, unsigned v) { return __hip_atomic_fetch_add(p, v, __ATOMIC_RELAXED, __HIP_MEMORY_SCOPE_AGENT); }
__device__ __forceinline__ unsigned xb_xcc_id() { return (unsigned)__builtin_amdgcn_s_getreg((3 << 11) | 20) & 0xFu; }
#define XB_SPIN(cond, bar) do { unsigned _sp = 0; while (cond) { __builtin_amdgcn_s_sleep(1); \
    if ((++_sp & 255u) == 0u) { if (xb_ld(&(bar)[XB_TMO])) break; if (_sp > XB_SPIN_CAP) { atomicAdd(&(bar)[XB_TMO], 1u); break; } } } } while (0)

struct XcdBarrier {
    unsigned* bar; unsigned x;
    volatile LAS unsigned* st;
};

__device__ __forceinline__ XcdBarrier xcd_barrier_post(unsigned* bar, volatile LAS unsigned* st) {
    XcdBarrier b; b.bar = bar; b.x = xb_xcc_id(); b.st = st;
    if (threadIdx.x == 0) (void)xb_add(&bar[XB_XCNT(b.x)], 1u);
    return b;
}
__device__ __forceinline__ void xcd_barrier_complete(unsigned* bar, unsigned x, unsigned& nloc, unsigned& nx) {
    const unsigned G = gridDim.x * gridDim.y * gridDim.z;
    unsigned sum, cnt, mine, sp = 0u;
    for (;;) {
        sum = 0u; cnt = 0u; mine = 0u;
#pragma unroll
        for (unsigned j = 0; j < 16; ++j) { const unsigned c = xb_ld(&bar[XB_XCNT(j)]); sum += c; cnt += (c > 0u) ? 1u : 0u; mine = (j == x) ? c : mine; }
        if (sum == G) break;
        __builtin_amdgcn_s_sleep(1);
        if ((++sp & 255u) == 0u) { if (xb_ld(&bar[XB_TMO])) break; if (sp > XB_SPIN_CAP) { atomicAdd(&bar[XB_TMO], 1u); break; } }
    }
    nloc = mine > 0u ? mine : 1u; nx = cnt > 0u ? cnt : 1u;
}

__device__ __forceinline__ void xcd_barrier(const XcdBarrier& b) {
    asm volatile("s_waitcnt vmcnt(0)" ::: "memory");
    __syncthreads();
    if (threadIdx.x == 0) {
        unsigned* bar = b.bar;
        __builtin_amdgcn_s_waitcnt(0);
        unsigned nloc = b.st[0], nx = b.st[1];
        if (nloc == 0u) { xcd_barrier_complete(bar, b.x, nloc, nx); b.st[0] = nloc; b.st[1] = nx; }
        const unsigned old = xb_add(&bar[XB_XSUB(b.x)], 1u);
        const unsigned gen = old / nloc;
        if (old + 1u == (gen + 1u) * nloc) {
            __builtin_amdgcn_fence(__ATOMIC_RELEASE, "agent");
            asm volatile("s_waitcnt vmcnt(0)" ::: "memory");
            const unsigned og = xb_add(&bar[XB_TOP], 1u);
            const unsigned tg = og / nx;
            if (og + 1u == (tg + 1u) * nx) xb_add(&bar[XB_TOPGEN], 1u);
            else XB_SPIN(xb_ld(&bar[XB_TOPGEN]) == tg, bar);
            __builtin_amdgcn_fence(__ATOMIC_ACQUIRE, "agent");
            xb_add(&bar[XB_XGEN(b.x)], 1u);
            asm volatile("s_waitcnt vmcnt(0)" ::: "memory");
        } else {
            XB_SPIN(xb_ld(&bar[XB_XGEN(b.x)]) == gen, bar);
            __builtin_amdgcn_fence(__ATOMIC_ACQUIRE, "agent");
            asm volatile("s_waitcnt vmcnt(0)" ::: "memory");
        }
    }
    __syncthreads();
}

__device__ __forceinline__ void tr_item(const float* W, int ldw, int srccol0, const float* g, bf16* Bt, int ldb, int dstrow0, int k0, int koff, LAS float* scr, int lane) {
    float tv[32]; const float* Wp = W + (size_t)(k0 + (lane >> 5)) * ldw + srccol0 + (lane & 31);
#pragma unroll
    for (int i = 0; i < 32; ++i) tv[i] = Wp[(size_t)(2 * i) * ldw];
    __builtin_amdgcn_sched_barrier(0);
#pragma unroll
    for (int i = 0; i < 32; ++i) { const int kk = 2 * i + (lane >> 5); float v = tv[i]; if (g) v *= g[k0 + kk]; scr[kk * 33 + (lane & 31)] = v; }
    LDS_WAIT(); asm volatile("" ::: "memory");
    const int c = lane & 7;
#pragma unroll
    for (int j = 0; j < 4; ++j) { const int n = (lane >> 3) + 8 * j; const LAS float* s = scr + (8 * c) * 33 + n;
        v4u o; o.x = pk2(s[0 * 33], s[1 * 33]); o.y = pk2(s[2 * 33], s[3 * 33]); o.z = pk2(s[4 * 33], s[5 * 33]); o.w = pk2(s[6 * 33], s[7 * 33]);
        *(v4u*)(Bt + (size_t)(dstrow0 + n) * ldb + koff + k0 + 8 * c) = o; }
    LDS_WAIT(); asm volatile("" ::: "memory");
}
__device__ __forceinline__ void fold_item(const float* L, int ldl, int kl0, const float* sc, const float* R, int J, bf16* Bt, int kd0, int n0, int lane) {
    float acc[8];
#pragma unroll
    for (int i = 0; i < 8; ++i) acc[i] = 0.f;
    const float* Lp = L + (size_t)kl0 * ldl; const float* Rp = R + n0 + lane;
#pragma unroll 1
    for (int j = 0; j < J; j += 16) { float wv[16];
#pragma unroll
        for (int u = 0; u < 16; ++u) wv[u] = Rp[(size_t)(j + u) * 1024];
        __builtin_amdgcn_sched_barrier(0);
#pragma unroll
        for (int u = 0; u < 16; ++u) { const float w = sc ? wv[u] * sc[j + u] : wv[u];
#pragma unroll
            for (int i = 0; i < 8; ++i) acc[i] += Lp[i * ldl + j + u] * w; } }
    v4u o; o.x = pk2(acc[0], acc[1]); o.y = pk2(acc[2], acc[3]); o.z = pk2(acc[4], acc[5]); o.w = pk2(acc[6], acc[7]);
    *(v4u*)(Bt + (size_t)(n0 + lane) * 1024 + kd0) = o;
}

struct Args { const float* in[22]; float* out; unsigned char* ws; };
constexpr int I_GU = 16 * 176, I_D = 44 * 32, I_WIN = 16 * 56, I_WV = 16 * 16, I_WO = 8 * 32, I_FOLD = 1024;
constexpr int I_LAYER = 2 * I_GU + 2 * I_D + I_WIN + I_WV + I_WO + I_FOLD;

__device__ __forceinline__ void prologue(const Args& a, LAS unsigned char* lds, int gw, int NGW, int wave, int lane) {
    LAS float* scr = (LAS float*)(lds + wave * 16384);
    unsigned char* ws = a.ws;
    for (int it = gw; it < NLAYER * I_LAYER; it += NGW) {
        const int l = it / I_LAYER; int r = it % I_LAYER;
        unsigned char* wl = ws + WS_W + (size_t)l * W_LAYER;
        if (r < 2 * I_GU) {
            const int f = r / I_GU; r %= I_GU; const int kb = r / 176, nb = r % 176, cc = 32 * nb, pn = cc >> 8, bj = (cc >> 7) & 1, j = cc & 127;
            const float* Wg = a.in[f ? 19 : 2] + (size_t)l * DM * DFF; const float* Wu = a.in[f ? 20 : 3] + (size_t)l * DM * DFF; const float* g = a.in[f ? 18 : 1] + l * DM;
            tr_item(bj ? Wu : Wg, DFF, 128 * pn + j, g, (bf16*)(wl + (f ? WO_GU2 : WO_GU1)), DM, cc, 64 * kb, 0, scr, lane); continue; }
        r -= 2 * I_GU;
        if (r < 2 * I_D) { const int f = r / I_D; r %= I_D; const int kb = r / 32, nb = r % 32;
            tr_item(a.in[f ? 21 : 4] + (size_t)l * DFF * DM, DM, 32 * nb, nullptr, (bf16*)(wl + (f ? WO_D2 : WO_D1)), DFF, 32 * nb, 64 * kb, 0, scr, lane); continue; }
        r -= 2 * I_D;
        if (r < I_WIN) { const int kb = r / 56, nb = r % 56, cc = 32 * nb; int src;
            if (cc < 512) { const int pn = cc >> 8, bj = (cc >> 7) & 1, j = cc & 127; src = (bj ? 256 : 0) + 128 * pn + j; }
            else if (cc < 768) src = cc;
            else { const int t = cc - 768, which = t >> 9, t2 = t & 511, pn2 = t2 >> 8, bj = (t2 >> 7) & 1, wc = (t2 >> 5) & 3; src = 768 + which * 512 + 256 * pn2 + 64 * wc + 32 * bj; }
            tr_item(a.in[6] + (size_t)l * DM * INW, INW, src, a.in[5] + l * DM, (bf16*)(wl + WO_WIN), DM, cc, 64 * kb, 0, scr, lane); continue; }
        r -= I_WIN;
        if (r < I_WV) { const int kb = r / 16, nb = r % 16;
            tr_item(a.in[6] + (size_t)l * DM * INW, INW, 1792 + 32 * nb, a.in[5] + l * DM, (bf16*)(wl + WO_WV), DM, 32 * nb, 64 * kb, 0, scr, lane); continue; }
        r -= I_WV;
        const float* wout = a.in[17] + (size_t)l * DM * DM;
        if (r < I_WO) { const int kb = r / 32, nb = r % 32;
            tr_item(wout + (size_t)512 * DM, DM, 32 * nb, nullptr, (bf16*)(wl + WO_WO), DM, 32 * nb, 64 * kb, 512, scr, lane); continue; }
        r -= I_WO;
        { const int kg = r / 16, nb = r % 16, k0 = 8 * kg;
            if (k0 < 256) fold_item(a.in[11] + (size_t)l * 65536, 256, k0, nullptr, wout, 256, (bf16*)(wl + WO_WO), k0, 64 * nb, lane);
            else { const int gi = (k0 - 256) >> 6, c0 = (k0 - 256) & 63;
                fold_item(a.in[12] + (size_t)l * 16384 + gi * 4096, 64, c0, a.in[13] + l * 256 + 64 * gi, wout + (size_t)(256 + 64 * gi) * DM, 64, (bf16*)(wl + WO_WO), k0, 64 * nb, lane); } }
    }
    const float* x = a.in[0]; bf16* XB = (bf16*)(ws + WS_XB); float* SS = (float*)(ws + WS_SS);
    for (int m0 = gw * 4; m0 < MTOK; m0 += NGW * 4) {
        f32x4 v[4][4];
#pragma unroll
        for (int q = 0; q < 4; ++q) { const f32x4* xr = (const f32x4*)(x + (size_t)(m0 + q) * DM) + lane;
#pragma unroll
            for (int j = 0; j < 4; ++j) v[q][j] = xr[64 * j]; }
        __builtin_amdgcn_sched_barrier(0);
#pragma unroll
        for (int q = 0; q < 4; ++q) { float s = 0.f;
#pragma unroll
            for (int j = 0; j < 4; ++j) s += (v[q][j].x * v[q][j].x + v[q][j].y * v[q][j].y) + (v[q][j].z * v[q][j].z + v[q][j].w * v[q][j].w);
            s = wave_sum(s);
            v2u* o8 = (v2u*)(XB + (size_t)(m0 + q) * DM) + lane;
#pragma unroll
            for (int j = 0; j < 4; ++j) { v2u w; w.x = pk2(v[q][j].x, v[q][j].y); w.y = pk2(v[q][j].z, v[q][j].w); o8[64 * j] = w; }
            if (lane == 0) SS[m0 + q] = s; }
    }
    for (int i = gw * 64 + lane; i < 5 * MTOK; i += NGW * 64) SS[MTOK + i] = 0.f;
}

#define SCHED_FENCE() __builtin_amdgcn_sched_barrier(0)
__device__ __forceinline__ void attn_unit(int b, int h, int r, int cb, const bf16* Q, const bf16* K, const bf16* VT, const LAS float* rpbs, bf16* Z, int lane) {
    const int fr = lane & 15, fq = lane >> 4;
    const int r0 = min(max(r - 4, 0), 56), kstart = min(max(16 * cb - 8, 0), 32), qcol = 16 * cb + fr, c0 = min(max(qcol - 8, 0), 48);
    const size_t tokb = (size_t)b * SEQ;
    const bf16* qp = Q + (tokb + r * 64 + qcol) * 512 + h * 64 + 8 * fq;
    const bf16x8 q0 = *(const bf16x8*)qp, q1 = *(const bf16x8*)(qp + 32);
    const char* kb = (const char*)(K + (tokb + r0 * 64 + kstart) * 512 + h * 64);
    const unsigned koff = (unsigned)((8 * (fr >> 2) + (fr & 3)) * 512 + 8 * fq) * 2u;
    bf16x8 kf[8][2][2];
#pragma unroll
    for (int i = 0; i < 8; ++i)
#pragma unroll
        for (int t = 0; t < 2; ++t)
#pragma unroll
            for (int ks = 0; ks < 2; ++ks) kf[i][t][ks] = *(const bf16x8*)(kb + (size_t)i * 65536 + (koff + t * 4096u + ks * 64u));
    SCHED_FENCE();
    f32x4 s[8][2];
#pragma unroll
    for (int i = 0; i < 8; ++i)
#pragma unroll
        for (int t = 0; t < 2; ++t) { f32x4 c = (f32x4){0.f, 0.f, 0.f, 0.f};
            c = __builtin_amdgcn_mfma_f32_16x16x32_bf16(kf[i][t][0], q0, c, 0, 0, 0); c = __builtin_amdgcn_mfma_f32_16x16x32_bf16(kf[i][t][1], q1, c, 0, 0, 0); s[i][t] = c; }
    SCHED_FENCE();
    const char* vb = (const char*)(VT + (size_t)(h * 64) * MTOK + tokb + r0 * 64 + kstart);
    const unsigned voff = (unsigned)(16 * (fr >> 2) + (fr & 3)) * (unsigned)(MTOK * 2) + 16u * fq;
    bf16x8 vf[8][4];
#pragma unroll
    for (int i = 0; i < 8; ++i)
#pragma unroll
        for (int jd = 0; jd < 4; ++jd) vf[i][jd] = *(const bf16x8*)(vb + (size_t)jd * (4 * MTOK * 2) + (voff + i * 128u));
    SCHED_FENCE();
    int dcc[8]; bool val[8];
#pragma unroll
    for (int j = 0; j < 8; ++j) { const int kc = kstart + 8 * fq + j, dc = kc - qcol + 15; val[j] = (kc >= c0) && (kc < c0 + 16); dcc[j] = min(max(dc, 0), 30); }
    float mx = -3.0e38f;
#pragma unroll
    for (int i = 0; i < 8; ++i) { const LAS float* bp = rpbs + h * 465 + (r0 + i - r + 7) * 31;
#pragma unroll
        for (int t = 0; t < 2; ++t)
#pragma unroll
            for (int e = 0; e < 4; ++e) { const int j = 4 * t + e; const float v = val[j] ? s[i][t][e] + bp[dcc[j]] : -1.0e30f; s[i][t][e] = v; mx = fmaxf(mx, v); } }
    mx = fmaxf(mx, __shfl_xor(mx, 16)); mx = fmaxf(mx, __shfl_xor(mx, 32));
    float l = 0.f; bf16x8 pb[8];
#pragma unroll
    for (int i = 0; i < 8; ++i) { float p[8];
#pragma unroll
        for (int t = 0; t < 2; ++t)
#pragma unroll
            for (int e = 0; e < 4; ++e) { const float pv = __expf(s[i][t][e] - mx); p[4 * t + e] = pv; l += pv; }
        v4u w; w.x = pk2(p[0], p[1]); w.y = pk2(p[2], p[3]); w.z = pk2(p[4], p[5]); w.w = pk2(p[6], p[7]);
        pb[i] = __builtin_bit_cast(bf16x8, w); }
    l += __shfl_xor(l, 16); l += __shfl_xor(l, 32);
    SCHED_FENCE();
    f32x4 o[4];
#pragma unroll
    for (int jd = 0; jd < 4; ++jd) o[jd] = (f32x4){0.f, 0.f, 0.f, 0.f};
#pragma unroll
    for (int i = 0; i < 8; ++i)
#pragma unroll
        for (int jd = 0; jd < 4; ++jd) o[jd] = __builtin_amdgcn_mfma_f32_16x16x32_bf16(vf[i][jd], pb[i], o[jd], 0, 0, 0);
    const float il = 1.0f / l;
    bf16* zp = Z + (tokb + r * 64 + qcol) * 1024 + 512 + h * 64 + 16 * fq;
    v4u w0, w1;
    w0.x = pk2(o[0][0] * il, o[0][1] * il); w0.y = pk2(o[0][2] * il, o[0][3] * il); w0.z = pk2(o[1][0] * il, o[1][1] * il); w0.w = pk2(o[1][2] * il, o[1][3] * il);
    w1.x = pk2(o[2][0] * il, o[2][1] * il); w1.y = pk2(o[2][2] * il, o[2][3] * il); w1.z = pk2(o[3][0] * il, o[3][1] * il); w1.w = pk2(o[3][2] * il, o[3][3] * il);
    *(v4u*)zp = w0; *(v4u*)(zp + 8) = w1;
    SCHED_FENCE();
}
__device__ __forceinline__ void conv_load(const bf16* cp, int tb, unsigned short (&raw)[38]) {
#pragma unroll
    for (int j = 0; j < 38; ++j) raw[j] = cp[(ptrdiff_t)(tb - 15) * 256 + j * 256];
}
__device__ __forceinline__ void conv_item(int item, const bf16* CU, const float* dw, const float* dwb, const float* lng, const float* lnb, bf16* Z, LAS float* st, int tid) {
    const int b = item >> 6, t0 = (item & 63) * 64, c = tid & 255, half = tid >> 8, lane = tid & 63, wave = tid >> 6;
    const bf16* cp = CU + (size_t)b * SEQ * 256 + c;
    unsigned short raw[38], rawn[38];
    conv_load(cp, t0 + half * 32, raw);
    float w[31];
#pragma unroll
    for (int k = 0; k < 31; ++k) w[k] = dw[k * 256 + c];
    const float bias = dwb[c];
#pragma unroll
    for (int ch = 0; ch < 4; ++ch) { const int tb = t0 + half * 32 + ch * 8;
        if (ch < 3) conv_load(cp, tb + 8, rawn);
        SCHED_FENCE();
        float in[38];
#pragma unroll
        for (int j = 0; j < 38; ++j) { const int tt = tb - 15 + j; in[j] = (tt >= 0 && tt < SEQ) ? bf2f(raw[j]) : 0.f; }
#pragma unroll
        for (int o = 0; o < 8; ++o) { float acc = bias;
#pragma unroll
            for (int k = 0; k < 31; ++k) acc += w[k] * in[o + k];
            st[(half * 32 + ch * 8 + o) * 256 + c] = acc; }
        SCHED_FENCE();
        if (ch < 3) {
#pragma unroll
            for (int j = 0; j < 38; ++j) raw[j] = rawn[j]; } }
    __syncthreads();
    const f32x4 g4 = *(const f32x4*)(lng + 4 * lane), b4 = *(const f32x4*)(lnb + 4 * lane);
    f32x4 v[8];
#pragma unroll
    for (int tt = 0; tt < 8; ++tt) v[tt] = *(const LAS f32x4*)(st + (8 * wave + tt) * 256 + 4 * lane);
#pragma unroll
    for (int tt = 0; tt < 8; ++tt) { const int tok = 8 * wave + tt;
        const float mean = wave_sum((v[tt].x + v[tt].y) + (v[tt].z + v[tt].w)) * (1.0f / 256.0f); const f32x4 d = v[tt] - mean;
        const float var = wave_sum((d.x * d.x + d.y * d.y) + (d.z * d.z + d.w * d.w)) * (1.0f / 256.0f); const float rstd = rsqrtf(var + EPS);
        f32x4 y = d * rstd * g4 + b4;
        y.x *= pg8::fsigmoid(y.x); y.y *= pg8::fsigmoid(y.y); y.z *= pg8::fsigmoid(y.z); y.w *= pg8::fsigmoid(y.w);
        v2u o; o.x = pk2(y.x, y.y); o.y = pk2(y.z, y.w);
        *(v2u*)(Z + ((size_t)b * SEQ + t0 + tok) * 1024 + 4 * lane) = o; }
    __syncthreads();
}
template <int W> __device__ __forceinline__ void pool_compute(const float (&in)[48], int tb, bf16* zp) {
#pragma unroll
    for (int o = 0; o < 32; ++o) { float sum = 0.f;
#pragma unroll
        for (int k = 0; k < W; ++k) sum += in[o + 8 - W / 2 + k];
        const int t = tb + o, lo = max(t - W / 2, 0), hi = min(t - W / 2 + W, SEQ);
        const float mixed = sum / (float)(hi - lo) - in[o + 8];
        zp[(size_t)o * 1024] = (bf16)(pk2(mixed, 0.f) & 0xffffu); }
}
__device__ __forceinline__ void pool_item(int item, const bf16* P, bf16* Z, int tid) {
    const int b = item >> 6, t0 = (item & 63) * 64, c = tid & 255, half = tid >> 8, g = __builtin_amdgcn_readfirstlane(c >> 6), tb = t0 + half * 32;
    const bf16* pc = P + (size_t)b * SEQ * 256 + c;
    unsigned short raw[48];
#pragma unroll
    for (int j = 0; j < 48; ++j) raw[j] = pc[(ptrdiff_t)(tb - 8) * 256 + j * 256];
    SCHED_FENCE();
    float in[48];
#pragma unroll
    for (int j = 0; j < 48; ++j) { const int tt = tb - 8 + j; in[j] = (tt >= 0 && tt < SEQ) ? bf2f(raw[j]) : 0.f; }
    bf16* zp = Z + ((size_t)b * SEQ + tb) * 1024 + 256 + c;
    if (g == 0) pool_compute<2>(in, tb, zp); else if (g == 1) pool_compute<4>(in, tb, zp); else if (g == 2) pool_compute<8>(in, tb, zp); else pool_compute<16>(in, tb, zp);
    SCHED_FENCE();
}

__global__ void __launch_bounds__(512, 2) fwd_megakernel(Args a) {
    extern __shared__ __attribute__((aligned(16))) unsigned char lds_raw[];
    LAS unsigned char* lds = (LAS unsigned char*)lds_raw;
    cg::grid_group grid = cg::this_grid();
    const int tid = threadIdx.x, lane = tid & 63, wave = __builtin_amdgcn_readfirstlane(tid >> 6);
    const int G = gridDim.x, bid = blockIdx.x;
    const int vcu = (G % 8 == 0) ? (bid % 8) * (G / 8) + bid / 8 : bid;
    unsigned char* ws = a.ws;
    float* SS = (float*)(ws + WS_SS); bf16* XB = (bf16*)(ws + WS_XB); bf16* H = (bf16*)(ws + WS_H); bf16* Z = (bf16*)(ws + WS_Z);
    bf16 *CU = (bf16*)(ws + WS_CU), *P = (bf16*)(ws + WS_P), *Qb = (bf16*)(ws + WS_Q), *Kb = (bf16*)(ws + WS_K), *VT = (bf16*)(ws + WS_VT);

    { volatile LAS unsigned* misc = (volatile LAS unsigned*)(lds + MISC_OFF); if (tid < 16) misc[tid] = 0u; }
    __syncthreads();
    XcdBarrier bar = xcd_barrier_post((unsigned*)(ws + WS_CTL) + CW_BAR, (volatile LAS unsigned*)(lds + MISC_OFF));
#ifndef REP_PRO
#define REP_PRO 1
#endif
#ifndef REP_MIX
#define REP_MIX 1
#endif
#ifndef REP_G1
#define REP_G1 1
#endif
#ifndef REP_G3
#define REP_G3 1
#endif
#ifndef REP_SYNC
#define REP_SYNC 1
#endif
#pragma unroll 1
    for (int rep = 0; rep < REP_PRO; ++rep) { prologue(a, lds, vcu * 8 + wave, G * 8, wave, lane); __syncthreads(); }
    grid.sync();

#pragma unroll 1
    for (int step = 0; step < 2 * NLAYER; ++step) {
        const int l = step >> 1, f = step & 1;
        unsigned char* wl = ws + WS_W + (size_t)l * W_LAYER;
        if (f == 1) {
            const float* ssm = SS + (size_t)(3 * l + 1) * MTOK;
#pragma unroll 1
            for (int rep = 0; rep < REP_G3; ++rep) {
            { pg8::Gemm g{XB, (const bf16*)(wl + WO_WIN), MTOK, NWIN, DM}; pg8::StaticOrder S; S.init(MTOK, NWIN, G, bid);
              pg8::EpiWin E{CU, P, Qb, Kb, ssm, a.in[14] + l * 64, a.in[15] + l * 64};
              pg8::gemm_phase<pg8::EpiWin, pg8::StaticOrder, true, true>(lds, g, S, E); }
            { pg8::Gemm g{(const bf16*)(wl + WO_WV), XB, 512, MTOK, DM}; pg8::StaticOrder S; S.init(512, MTOK, G, bid);
              pg8::EpiVT E{VT, ssm, MTOK};
              pg8::gemm_phase<pg8::EpiVT, pg8::StaticOrder, true, true>(lds, g, S, E); }
            }
#pragma unroll 1
            for (int rep = 0; rep < REP_SYNC; ++rep) xcd_barrier(bar);
#pragma unroll 1
            for (int rep = 0; rep < REP_MIX; ++rep) {
                int mt_ = threadIdx.x; asm volatile("" : "+v"(mt_));
                const int tid = mt_, lane = tid & 63, wave = __builtin_amdgcn_readfirstlane(tid >> 6);
                LAS float* rpbs = (LAS float*)(lds + RPB_OFF);
                const float* rpb = a.in[16] + (size_t)l * 3720;
                for (int i = tid; i < 3720; i += 512) rpbs[i] = rpb[i];
                __syncthreads();
                const int a0 = (int)((long)vcu * 2048 / G), a1 = (int)((long)(vcu + 1) * 2048 / G);
                for (int it = a0; it < a1; ++it) { const int bh = it >> 5, rp = it & 31;
                    attn_unit(bh >> 3, bh & 7, 2 * rp + (wave >> 2), wave & 3, Qb, Kb, VT, rpbs, Z, lane); }
                __syncthreads();
                const int c0i = (int)((long)vcu * 512 / G), c1i = (int)((long)(vcu + 1) * 512 / G);
                for (int it = c0i; it < c1i; ++it)
                    conv_item(it, CU, a.in[7] + (size_t)l * 31 * 256, a.in[8] + l * 256, a.in[9] + l * 256, a.in[10] + l * 256, Z, (LAS float*)lds, tid);
                for (int it = c0i; it < c1i; ++it) pool_item(it, P, Z, tid);
                __syncthreads();
            }
            xcd_barrier(bar);
            { pg8::Gemm g{Z, (const bf16*)(wl + WO_WO), MTOK, DM, DM}; pg8::StaticOrder S; S.init(MTOK, DM, G, bid);
              pg8::EpiResid E{a.out, a.out, XB, SS + (size_t)(3 * l + 2) * MTOK, 1.0f};
              pg8::gemm_phase<pg8::EpiResid, pg8::StaticOrder, true, true>(lds, g, S, E); }
            xcd_barrier(bar);
        }
#pragma unroll 1
        for (int rep = 0; rep < REP_G1; ++rep)
        { pg8::Gemm g{XB, (const bf16*)(wl + (f ? WO_GU2 : WO_GU1)), MTOK, NGU, DM}; pg8::StaticOrder S; S.init(MTOK, NGU, G, bid);
          pg8::EpiSwiglu E{H, DFF, SS + (size_t)(3 * l + (f ? 2 : 0)) * MTOK};
          pg8::gemm_phase<pg8::EpiSwiglu, pg8::StaticOrder, true, true>(lds, g, S, E); }
        xcd_barrier(bar);
        { pg8::Gemm g{H, (const bf16*)(wl + (f ? WO_D2 : WO_D1)), MTOK, DM, DFF}; pg8::StaticOrder S; S.init(MTOK, DM, G, bid);
          const bool last = (step == 2 * NLAYER - 1);
          pg8::EpiResid E{step == 0 ? a.in[0] : a.out, a.out, XB, last ? nullptr : SS + (size_t)(f ? 3 * (l + 1) : 3 * l + 1) * MTOK, 0.5f};
          pg8::gemm_phase<pg8::EpiResid, pg8::StaticOrder, true, true>(lds, g, S, E); }
        if (step != 2 * NLAYER - 1) xcd_barrier(bar);
    }
}

extern "C" void kernel_launch(void* const* d_in, const int* in_sizes, int n_in, void* d_out, int out_size, void* d_ws, size_t ws_size, hipStream_t stream) {
    static int grid = 0;
    if (grid == 0) {
        if (n_in != 22 || in_sizes[0] != MTOK * DM || out_size != MTOK * DM || ws_size < WS_END) { fprintf(stderr, "kernel_launch: unexpected shapes (n_in %d, in0 %d, out %d, ws %zu); nothing launched\n", n_in, n_in > 0 ? in_sizes[0] : -1, out_size, ws_size); grid = -1; return; }
        int dev = 0, cus = 0, per_cu = 0;
        if (hipGetDevice(&dev) != hipSuccess || hipDeviceGetAttribute(&cus, hipDeviceAttributeMultiprocessorCount, dev) != hipSuccess) { grid = -1; return; }
        if (hipFuncSetAttribute((const void*)fwd_megakernel, hipFuncAttributeMaxDynamicSharedMemorySize, LDS_BYTES) != hipSuccess) { fprintf(stderr, "kernel_launch: hipFuncSetAttribute failed\n"); grid = -1; return; }
        if (hipOccupancyMaxActiveBlocksPerMultiprocessor(&per_cu, (const void*)fwd_megakernel, 512, LDS_BYTES) != hipSuccess || per_cu < 1) { fprintf(stderr, "kernel_launch: occupancy query gave %d\n", per_cu); (void)hipGetLastError(); per_cu = 1; }
        grid = cus * 1;
    }
    if (grid < 0) return;
    if (hipMemsetAsync((char*)d_ws + WS_CTL, 0, CTL_ZERO_BYTES, stream) != hipSuccess) { fprintf(stderr, "kernel_launch: hipMemsetAsync failed\n"); return; }
    Args a{};
    for (int i = 0; i < 22; ++i) a.in[i] = (const float*)d_in[i];
    a.out = (float*)d_out; a.ws = (unsigned char*)d_ws;
    void* args[] = {&a};
    hipError_t e = hipLaunchCooperativeKernel((const void*)fwd_megakernel, dim3(grid), dim3(512), args, LDS_BYTES, stream);
    if (e != hipSuccess) fprintf(stderr, "kernel_launch: cooperative launch failed: %s (grid %d)\n", hipGetErrorString(e), grid);
}
```

```cpp
#include <hip/hip_runtime.h>
#include <hip/hip_cooperative_groups.h>
#include <cstdio>
#include <cstdint>
namespace cg = cooperative_groups;
namespace pg8 {
#define PG8_LAS __attribute__((address_space(3)))
typedef unsigned short bf16_t;
typedef short bf16x8 __attribute__((ext_vector_type(8)));
typedef float f32x4 __attribute__((ext_vector_type(4)));
typedef unsigned u32x4 __attribute__((ext_vector_type(4)));
constexpr int BM = 256, BK = 64, HALF = 128, HTB = HALF * BK * 2  , STAGE_BYTES = 8 * HTB, NXCD = 8, WGM = 8;

__host__ __device__ __forceinline__ int lds_byte(int r, int c) { const int st = (r >> 4) * 2 + (c >> 5), rr = r & 15, cc = c & 31, ob = rr * 64 + cc * 2; return st * 1024 + (ob ^ (((ob >> 9) & 1) << 5)); }
__host__ __device__ __forceinline__ void stage_rc(int b, int& R, int& C) { const int st = b / 1024, sb = b % 1024, swz = sb ^ (((sb >> 9) & 1) << 5); R = (st >> 1) * 16 + swz / 64; C = (st & 1) * 32 + (swz % 64) / 2; }
__host__ __device__ __forceinline__ int perm32(int rho) { const int n = rho >> 4, i = rho & 15; return 8 * (i >> 2) + 4 * n + (i & 3); }

struct Unit { int pm, pn; };
struct Gemm { const bf16_t* A; const bf16_t* Bt; int M, N, K; };

struct StaticOrder {
    int nM, nN, nwg, G, c;
    __host__ __device__ void init(int M, int N, int G_, int c_) { nM = M / BM; nN = N / BM; nwg = nM * nN; G = G_; c = c_; }
    __host__ __device__ bool next(int i, Unit& u) const {
        const long L = (long)i * G + c; if (L >= nwg) return false;
        int wgid = (int)L; { const int q = nwg / NXCD, r = nwg % NXCD, xcd = wgid % NXCD, off = wgid / NXCD; wgid = (xcd < r ? xcd * (q + 1) : r * (q + 1) + (xcd - r) * q) + off; }
        const int nig = WGM * nN, gid = wgid / nig, fm = gid * WGM, gsz = (nM - fm) < WGM ? (nM - fm) : WGM;
        u.pm = fm + ((wgid % nig) % gsz); u.pn = (wgid % nig) / gsz; return true;
    }
    __device__ __forceinline__ void a_ready(const Unit&) const {}
    __device__ __forceinline__ void done(const Unit&) const {}
};

__device__ __forceinline__ unsigned cvt_pk_bf16(float lo, float hi) { unsigned r; asm volatile("v_cvt_pk_bf16_f32 %0, %1, %2" : "=v"(r) : "v"(lo), "v"(hi)); return r; }
typedef float f32x2 __attribute__((ext_vector_type(2)));
constexpr float NORM_EPS = 1e-6f;
__device__ __forceinline__ float fsigmoid(float x) { return __builtin_amdgcn_rcpf(1.0f + __expf(-x)); }
__device__ __forceinline__ float row_rstd(const float* ss, int row) { return rsqrtf(ss[row] * (1.0f / 1024.0f) + NORM_EPS); }

struct EpiSwiglu {
    static constexpr bool PERM = true, AFTER_DRAIN = false;
    bf16_t* H; int ldh; const float* ss;
    __device__ __forceinline__ void operator()(const f32x4 (&acc)[2][2][4][2], const Unit& u, int wr, int wc, int fr, int fq) const {
        const int row0 = u.pm * BM + wr * 64 + fr, col0 = u.pn * HALF + wc * 32 + 8 * fq;
#ifndef REP_EPI
#define REP_EPI 1
#endif
#if REP_EPI > 1
#pragma unroll 1
        for (int rep = 0; rep < REP_EPI; ++rep)
#endif
#pragma unroll
        for (int ai = 0; ai < 2; ++ai)
#pragma unroll
            for (int m = 0; m < 4; ++m) { const int row = row0 + ai * HALF + m * 16; const float rs = row_rstd(ss, row);
                float h[8];
#pragma unroll
                for (int n = 0; n < 2; ++n)
#pragma unroll
                    for (int e = 0; e < 4; ++e) { const float g = acc[ai][0][m][n][e] * rs, up = acc[ai][1][m][n][e] * rs; h[4 * n + e] = g * fsigmoid(g) * up; }
                u32x4 w; w.x = cvt_pk_bf16(h[0], h[1]); w.y = cvt_pk_bf16(h[2], h[3]); w.z = cvt_pk_bf16(h[4], h[5]); w.w = cvt_pk_bf16(h[6], h[7]);
                *(u32x4*)(H + (size_t)row * ldh + col0) = w; }
    }
};
struct EpiResid {
    static constexpr bool PERM = true, AFTER_DRAIN = false;
    const float* base; float* out; bf16_t* xb; float* ssn; float alpha;
    __device__ __forceinline__ void operator()(const f32x4 (&acc)[2][2][4][2], const Unit& u, int wr, int wc, int fr, int fq) const {
        const int row0 = u.pm * BM + wr * 64 + fr, col0 = u.pn * BM + wc * 32 + 8 * fq;
#pragma unroll
        for (int ai = 0; ai < 2; ++ai)
#pragma unroll
            for (int m = 0; m < 4; ++m) { const int row = row0 + ai * HALF + m * 16; float part = 0.f;
#pragma unroll
                for (int bj = 0; bj < 2; ++bj) { const size_t off = (size_t)row * 1024 + col0 + bj * HALF;
                    const f32x4 b0 = *(const f32x4*)(base + off), b1 = *(const f32x4*)(base + off + 4);
                    const f32x4 o0 = b0 + acc[ai][bj][m][0] * alpha, o1 = b1 + acc[ai][bj][m][1] * alpha;
                    *(f32x4*)(out + off) = o0; *(f32x4*)(out + off + 4) = o1;
                    if (ssn) { u32x4 w; w.x = cvt_pk_bf16(o0[0], o0[1]); w.y = cvt_pk_bf16(o0[2], o0[3]); w.z = cvt_pk_bf16(o1[0], o1[1]); w.w = cvt_pk_bf16(o1[2], o1[3]);
                        *(u32x4*)(xb + off) = w;
                        part += (o0[0] * o0[0] + o0[1] * o0[1]) + (o0[2] * o0[2] + o0[3] * o0[3]) + (o1[0] * o1[0] + o1[1] * o1[1]) + (o1[2] * o1[2] + o1[3] * o1[3]); } }
                if (ssn) { part += __shfl_xor(part, 16); part += __shfl_xor(part, 32); if (fq == 0) unsafeAtomicAdd(ssn + row, part); } }
    }
};
struct EpiWin {
    static constexpr bool PERM = true, AFTER_DRAIN = false;
    bf16_t *CU, *P, *Q, *Kq; const float* ss; const float *qg, *kg;
    __device__ __forceinline__ void operator()(const f32x4 (&acc)[2][2][4][2], const Unit& u, int wr, int wc, int fr, int fq) const {
        const int row0 = u.pm * BM + wr * 64 + fr, pn = u.pn;
        if (pn < 2) {
#pragma unroll
            for (int ai = 0; ai < 2; ++ai)
#pragma unroll
                for (int m = 0; m < 4; ++m) { const int row = row0 + ai * HALF + m * 16; const float rs = row_rstd(ss, row); float h[8];
#pragma unroll
                    for (int n = 0; n < 2; ++n)
#pragma unroll
                        for (int e = 0; e < 4; ++e) { const float a = acc[ai][0][m][n][e] * rs, g = acc[ai][1][m][n][e] * rs; h[4 * n + e] = a * fsigmoid(g); }
                    u32x4 w; w.x = cvt_pk_bf16(h[0], h[1]); w.y = cvt_pk_bf16(h[2], h[3]); w.z = cvt_pk_bf16(h[4], h[5]); w.w = cvt_pk_bf16(h[6], h[7]);
                    *(u32x4*)(CU + (size_t)row * 256 + pn * HALF + wc * 32 + 8 * fq) = w; }
        } else if (pn == 2) {
#pragma unroll
            for (int ai = 0; ai < 2; ++ai)
#pragma unroll
                for (int m = 0; m < 4; ++m) { const int row = row0 + ai * HALF + m * 16; const float rs = row_rstd(ss, row);
#pragma unroll
                    for (int bj = 0; bj < 2; ++bj) { const f32x4 v0 = acc[ai][bj][m][0] * rs, v1 = acc[ai][bj][m][1] * rs;
                        u32x4 w; w.x = cvt_pk_bf16(v0[0], v0[1]); w.y = cvt_pk_bf16(v0[2], v0[3]); w.z = cvt_pk_bf16(v1[0], v1[1]); w.w = cvt_pk_bf16(v1[2], v1[3]);
                        *(u32x4*)(P + (size_t)row * 256 + bj * HALF + wc * 32 + 8 * fq) = w; } }
        } else {
            const int which = (pn - 3) >> 1, head = 4 * ((pn - 3) & 1) + wc;
            const float* gp = (which ? kg : qg) + 8 * fq; const float post = which ? 1.0f : 0.125f;
            f32x4 gv[2][2];
#pragma unroll
            for (int bj = 0; bj < 2; ++bj)
#pragma unroll
                for (int n = 0; n < 2; ++n) gv[bj][n] = *(const f32x4*)(gp + 32 * bj + 4 * n) * post;
            bf16_t* dst = Q + head * 64 + 8 * fq;
#pragma unroll
            for (int ai = 0; ai < 2; ++ai)
#pragma unroll
                for (int m = 0; m < 4; ++m) { const int row = row0 + ai * HALF + m * 16; const float rs = row_rstd(ss, row);
                    f32x4 v[2][2]; float q = 0.f;
#pragma unroll
                    for (int bj = 0; bj < 2; ++bj)
#pragma unroll
                        for (int n = 0; n < 2; ++n) { v[bj][n] = acc[ai][bj][m][n] * rs; const f32x4 x = v[bj][n]; q += (x[0] * x[0] + x[1] * x[1]) + (x[2] * x[2] + x[3] * x[3]); }
                    q += __shfl_xor(q, 16); q += __shfl_xor(q, 32);
                    const float r2 = rsqrtf(q * (1.0f / 64.0f) + NORM_EPS);
#pragma unroll
                    for (int bj = 0; bj < 2; ++bj) { const f32x4 v0 = v[bj][0] * gv[bj][0] * r2, v1 = v[bj][1] * gv[bj][1] * r2;
                        u32x4 w; w.x = cvt_pk_bf16(v0[0], v0[1]); w.y = cvt_pk_bf16(v0[2], v0[3]); w.z = cvt_pk_bf16(v1[0], v1[1]); w.w = cvt_pk_bf16(v1[2], v1[3]);
                        if (which) { const int tb_ = row >> 12, ts_ = row & 4095, gr = ts_ >> 6, col = ts_ & 63;
                            *(u32x4*)(Kq + ((size_t)((tb_ * 8 + head) * 64 + gr) * 4096 + ((((col >> 2) & 1) * 2 + bj) * 8 + (col >> 3)) * 128 + (col & 3) * 32 + fq * 8)) = w; }
                        else *(u32x4*)(dst + (size_t)row * 512 + 32 * bj) = w; } }
        }
    }
};
struct EpiVT {
    static constexpr bool PERM = true, AFTER_DRAIN = false;
    bf16_t* VT; const float* ss; int ldv;
    __device__ __forceinline__ void operator()(const f32x4 (&acc)[2][2][4][2], const Unit& u, int wr, int wc, int fr, int fq) const {
        const int row0 = u.pm * BM + wr * 64 + fr, col0 = u.pn * BM + wc * 32 + 8 * fq;
        f32x4 rsv[2][2];
#pragma unroll
        for (int bj = 0; bj < 2; ++bj)
#pragma unroll
            for (int n = 0; n < 2; ++n) { const f32x4 s4 = *(const f32x4*)(ss + col0 + bj * HALF + 4 * n);
                rsv[bj][n] = (f32x4){rsqrtf(s4[0] * (1.0f / 1024.0f) + NORM_EPS), rsqrtf(s4[1] * (1.0f / 1024.0f) + NORM_EPS), rsqrtf(s4[2] * (1.0f / 1024.0f) + NORM_EPS), rsqrtf(s4[3] * (1.0f / 1024.0f) + NORM_EPS)}; }
#pragma unroll
        for (int ai = 0; ai < 2; ++ai)
#pragma unroll
            for (int m = 0; m < 4; ++m) { const int dim = row0 + ai * HALF + m * 16, hh = dim >> 6, d = dim & 63, jd = (d >> 2) & 3, frv = 4 * (d >> 4) + (d & 3);
#pragma unroll
                for (int bj = 0; bj < 2; ++bj) { const f32x4 v0 = acc[ai][bj][m][0] * rsv[bj][0], v1 = acc[ai][bj][m][1] * rsv[bj][1];
                    u32x4 w; w.x = cvt_pk_bf16(v0[0], v0[1]); w.y = cvt_pk_bf16(v0[2], v0[3]); w.z = cvt_pk_bf16(v1[0], v1[1]); w.w = cvt_pk_bf16(v1[2], v1[3]);
                    const int tok = col0 + bj * HALF, tb_ = tok >> 12, ts_ = tok & 4095, gr = ts_ >> 6, col = ts_ & 63;
                    *(u32x4*)(VT + ((size_t)((tb_ * 8 + hh) * 64 + gr) * 4096 + (jd * 8 + (col >> 3)) * 128 + frv * 8)) = w; } }
    }
};
template <class Epi, class Sched, bool ALIGN_EPI = false, bool SP2 = false>
__device__ __forceinline__ void gemm_phase(PG8_LAS unsigned char* lds, const Gemm g, const Sched& S, const Epi& E) {
    int tid_ = threadIdx.x; asm volatile("" : "+v"(tid_));
    const int tid = tid_, wid = __builtin_amdgcn_readfirstlane(tid >> 6), lane = tid & 63, wr = wid >> 2, wc = wid & 3, fr = lane & 15, fq = lane >> 4;
    const int K = g.K, nt = K / BK;
    unsigned voffA[2], voffB[2];
#pragma unroll
    for (int i = 0; i < 2; ++i) { int R, C; stage_rc(tid * 16 + i * 8192, R, C); const int Rb = Epi::PERM ? ((R & ~31) + perm32(R & 31)) : R;
        voffA[i] = (unsigned)(R * K + C) * 2u; voffB[i] = (unsigned)(Rb * K + C) * 2u; }
    const size_t kstep = (size_t)(BK * 2);
    const size_t hstep = (size_t)HALF * K * 2;
    const size_t tstep = 2 * hstep;
    const unsigned ldsw = (unsigned)wid * 1024u;
    const int aoff = lds_byte(wr * 64 + fr, fq * 8), boff = lds_byte(wc * 32 + fr, fq * 8);
#define PG8_SA(b, h) (((b) * 2 + (h)) * HTB)
#define PG8_SB(b, h) ((4 + (b) * 2 + (h)) * HTB)
#define PG8_STAGE(bufoff, gbase, voff) do { _Pragma("unroll") for (int _i = 0; _i < 2; ++_i) \
        __builtin_amdgcn_global_load_lds((const unsigned*)((const char*)(gbase) + (voff)[_i]), (PG8_LAS unsigned*)(lds + (bufoff) + ldsw + _i * 8192), 16, 0, 0); } while (0)
#define PG8_LDA(dst, b, h) do { _Pragma("unroll") for (int m = 0; m < 4; ++m) _Pragma("unroll") for (int k = 0; k < 2; ++k) dst[m][k] = *(const PG8_LAS bf16x8*)(lds + PG8_SA(b, h) + aoff + m * 2048 + k * 1024); } while (0)
#define PG8_LDB(dst, b, h) do { _Pragma("unroll") for (int n = 0; n < 2; ++n) _Pragma("unroll") for (int k = 0; k < 2; ++k) dst[n][k] = *(const PG8_LAS bf16x8*)(lds + PG8_SB(b, h) + boff + n * 2048 + k * 1024); } while (0)
#define PG8_MMA(ai, bj, At, Bt) do { __builtin_amdgcn_s_setprio(1); _Pragma("unroll") for (int m = 0; m < 4; ++m) _Pragma("unroll") for (int n = 0; n < 2; ++n) _Pragma("unroll") for (int k = 0; k < 2; ++k) \
        acc[ai][bj][m][n] = __builtin_amdgcn_mfma_f32_16x16x32_bf16(Bt[n][k], At[m][k], acc[ai][bj][m][n], 0, 0, 0); __builtin_amdgcn_s_setprio(0); } while (0)
#define PG8_WAIT_V(n) asm volatile("s_waitcnt vmcnt(" #n ")" ::: "memory")
#define PG8_WAIT_L(n) asm volatile("s_waitcnt lgkmcnt(" #n ")" ::: "memory")
#define PG8_BAR __builtin_amdgcn_s_barrier()
#define PG8_SCHED __builtin_amdgcn_sched_barrier(0)
    Unit cur, nxt; int ui = 0;
    if (!S.next(0, cur)) return;
    f32x4 acc[2][2][4][2];
#pragma unroll
    for (int a = 0; a < 2; ++a)
#pragma unroll
        for (int b = 0; b < 2; ++b)
#pragma unroll
            for (int m = 0; m < 4; ++m)
#pragma unroll
                for (int n = 0; n < 2; ++n) acc[a][b][m][n] = (f32x4){0.f, 0.f, 0.f, 0.f};
    bf16x8 At[4][2], B0[2][2], B1[2][2];
    const char* cA = (const char*)g.A + (size_t)cur.pm * tstep; const char* cB = (const char*)g.Bt + (size_t)cur.pn * tstep;
    S.a_ready(cur);
    if constexpr (SP2) {
        PG8_STAGE(PG8_SB(0, 0), cB, voffB); PG8_STAGE(PG8_SB(0, 1), cB + hstep, voffB); PG8_STAGE(PG8_SA(0, 0), cA, voffA); PG8_STAGE(PG8_SA(0, 1), cA + hstep, voffA);
        if (wr == 1) PG8_BAR;
        PG8_WAIT_V(2); PG8_BAR;
        PG8_STAGE(PG8_SB(1, 0), cB + kstep, voffB); PG8_STAGE(PG8_SA(1, 0), cA + kstep, voffA); PG8_STAGE(PG8_SB(1, 1), cB + hstep + kstep, voffB);
        PG8_WAIT_V(6); PG8_BAR;
    } else {
        PG8_STAGE(PG8_SB(0, 0), cB, voffB); PG8_STAGE(PG8_SA(0, 0), cA, voffA); PG8_STAGE(PG8_SB(0, 1), cB + hstep, voffB); PG8_STAGE(PG8_SA(0, 1), cA + hstep, voffA);
        if (wr == 1) PG8_BAR;
        PG8_WAIT_V(4); PG8_BAR;
        PG8_STAGE(PG8_SB(1, 0), cB + kstep, voffB); PG8_STAGE(PG8_SA(1, 0), cA + kstep, voffA); PG8_STAGE(PG8_SB(1, 1), cB + hstep + kstep, voffB);
        PG8_WAIT_V(6); PG8_BAR;
    }
    for (;;) {
        const bool has_next = S.next(ui + 1, nxt);
        const char* nA = has_next ? (const char*)g.A + (size_t)nxt.pm * tstep : cA; const char* nB = has_next ? (const char*)g.Bt + (size_t)nxt.pn * tstep : cB;
        for (int t = 0; t < nt; t += 2) {
            const bool last = (t == nt - 2);
            const char* a1 = cA + (size_t)(t + 1) * kstep;
            const char* a2 = last ? nA : cA + (size_t)(t + 2) * kstep; const char* b2 = last ? nB : cB + (size_t)(t + 2) * kstep;
            const char* a3 = a2 + kstep; const char* b3 = b2 + kstep;
            if (last && has_next) S.a_ready(nxt);
            if constexpr (SP2) {
            PG8_LDB(B0, 0, 0); PG8_LDB(B1, 0, 1); PG8_SCHED; PG8_LDA(At, 0, 0); PG8_STAGE(PG8_SA(1, 1), a1 + hstep, voffA);
            PG8_WAIT_V(8); PG8_WAIT_L(0); PG8_BAR; PG8_MMA(0, 0, At, B0); PG8_MMA(0, 1, At, B1); PG8_BAR; PG8_SCHED;
            PG8_LDA(At, 0, 1); PG8_STAGE(PG8_SB(0, 0), b2, voffB); PG8_STAGE(PG8_SB(0, 1), b2 + hstep, voffB); PG8_STAGE(PG8_SA(0, 0), a2, voffA);
            PG8_WAIT_V(8); PG8_WAIT_L(0); PG8_BAR; PG8_MMA(1, 0, At, B0); PG8_MMA(1, 1, At, B1); PG8_BAR; PG8_SCHED;
            PG8_LDB(B0, 1, 0); PG8_LDB(B1, 1, 1); PG8_SCHED; PG8_LDA(At, 1, 0); PG8_STAGE(PG8_SA(0, 1), a2 + hstep, voffA);
            PG8_WAIT_V(8); PG8_WAIT_L(0); PG8_BAR; PG8_MMA(0, 0, At, B0); PG8_MMA(0, 1, At, B1); PG8_BAR; PG8_SCHED;
            PG8_LDA(At, 1, 1); PG8_STAGE(PG8_SB(1, 0), b3, voffB); PG8_STAGE(PG8_SB(1, 1), b3 + hstep, voffB); PG8_STAGE(PG8_SA(1, 0), a3, voffA);
            PG8_WAIT_V(8); PG8_WAIT_L(0); PG8_BAR; PG8_MMA(1, 0, At, B0); PG8_MMA(1, 1, At, B1); PG8_BAR; PG8_SCHED;
            } else {
            PG8_LDB(B0, 0, 0); PG8_SCHED; PG8_LDA(At, 0, 0); PG8_STAGE(PG8_SA(1, 1), a1 + hstep, voffA);
            PG8_WAIT_L(8); PG8_BAR; PG8_WAIT_L(0); PG8_MMA(0, 0, At, B0); PG8_BAR; PG8_SCHED;
            PG8_LDB(B1, 0, 1); PG8_STAGE(PG8_SB(0, 0), b2, voffB);
            PG8_BAR; PG8_WAIT_L(0); PG8_MMA(0, 1, At, B1); PG8_BAR;
            PG8_LDA(At, 0, 1); PG8_STAGE(PG8_SA(0, 0), a2, voffA);
            PG8_BAR; PG8_WAIT_L(0); PG8_MMA(1, 0, At, B0); PG8_BAR; PG8_SCHED;
            PG8_STAGE(PG8_SB(0, 1), b2 + hstep, voffB);
            PG8_WAIT_V(6); PG8_BAR; PG8_MMA(1, 1, At, B1); PG8_BAR;
            PG8_LDB(B0, 1, 0); PG8_SCHED; PG8_LDA(At, 1, 0); PG8_STAGE(PG8_SA(0, 1), a2 + hstep, voffA);
            PG8_WAIT_L(8); PG8_BAR; PG8_WAIT_L(0); PG8_MMA(0, 0, At, B0); PG8_BAR; PG8_SCHED;
            PG8_LDB(B1, 1, 1); PG8_STAGE(PG8_SB(1, 0), b3, voffB);
            PG8_BAR; PG8_WAIT_L(0); PG8_MMA(0, 1, At, B1); PG8_BAR;
            PG8_LDA(At, 1, 1); PG8_STAGE(PG8_SA(1, 0), a3, voffA);
            PG8_BAR; PG8_WAIT_L(0); PG8_MMA(1, 0, At, B0); PG8_BAR; PG8_SCHED;
            PG8_STAGE(PG8_SB(1, 1), b3 + hstep, voffB);
            PG8_WAIT_V(6); PG8_BAR; PG8_MMA(1, 1, At, B1); PG8_BAR;
            }
        }
        if constexpr (ALIGN_EPI) { if (wr == 0) PG8_BAR; }
        if constexpr (!Epi::AFTER_DRAIN) { E(acc, cur, wr, wc, fr, fq); S.done(cur); }
        if (!has_next) break;
#pragma unroll
        for (int a = 0; a < 2; ++a)
#pragma unroll
            for (int b = 0; b < 2; ++b)
#pragma unroll
                for (int m = 0; m < 4; ++m)
#pragma unroll
                    for (int n = 0; n < 2; ++n) acc[a][b][m][n] = (f32x4){0.f, 0.f, 0.f, 0.f};
        cur = nxt; cA = nA; cB = nB; ++ui;
        if constexpr (ALIGN_EPI) { if (wr == 1) PG8_BAR; }
    }
    PG8_WAIT_V(0);
    if constexpr (!ALIGN_EPI) { if (wr == 0) PG8_BAR; }
    PG8_BAR;
    if constexpr (Epi::AFTER_DRAIN) { E.fused(acc, cur, wr, wc, fr, fq, lds, wid, lane); S.done(cur); }
#undef PG8_SA
#undef PG8_SB
#undef PG8_STAGE
#undef PG8_LDA
#undef PG8_LDB
#undef PG8_MMA
#undef PG8_WAIT_V
#undef PG8_WAIT_L
#undef PG8_BAR
#undef PG8_SCHED
}
}

constexpr int DM = 1024, NB = 8, SEQ = 4096, MTOK = NB * SEQ, DFF = 2816, INW = 2304, NLAYER = 2, NHEAD = 8;
constexpr int NGU = 2 * DFF;
constexpr int NWIN = 1792;
constexpr float EPS = 1e-6f;
constexpr size_t MiB = 1u << 20;
constexpr size_t WS_CTL = 0, CTL_ZERO_BYTES = 65536; constexpr int CW_BAR = 4096;
constexpr size_t WS_SS = 1 * MiB;
constexpr size_t WS_W = 2 * MiB, W_LAYER = 40 * MiB;
constexpr size_t WO_GU1 = 0, WO_D1 = 11 * MiB, WO_WIN = WO_D1 + 5632 * 1024, WO_WV = WO_WIN + 3584 * 1024, WO_WO = WO_WV + 1 * MiB, WO_GU2 = WO_WO + 2 * MiB, WO_D2 = WO_GU2 + 11 * MiB;
static_assert(WO_D2 + 5632 * 1024 <= W_LAYER, "weights per layer");
constexpr size_t WS_XB = 82 * MiB;
constexpr size_t WS_H = 146 * MiB;
constexpr size_t WS_CU = WS_H, WS_P = WS_CU + 16 * MiB, WS_Q = WS_P + 16 * MiB, WS_K = WS_Q + 32 * MiB, WS_VT = WS_K + 32 * MiB;
constexpr size_t WS_Z = 322 * MiB, WS_END = 386 * MiB;
static_assert(WS_VT + 32 * MiB <= WS_Z && WS_W + 2 * W_LAYER <= WS_XB, "d_ws map");
constexpr int LDS_BYTES = 131072 + 30720 + 64;
constexpr int RPB_OFF = 131072, MISC_OFF = 131072 + 30720;

#define LAS __attribute__((address_space(3)))
typedef unsigned short bf16;
typedef unsigned v4u __attribute__((ext_vector_type(4)));
typedef unsigned v2u __attribute__((ext_vector_type(2)));
typedef float f32x4 __attribute__((ext_vector_type(4)));
typedef short bf16x8 __attribute__((ext_vector_type(8)));
#define LDS_WAIT() asm volatile("s_waitcnt lgkmcnt(0)" ::: "memory")
__device__ __forceinline__ float bf2f(unsigned short v) { return __uint_as_float((unsigned)v << 16); }
__device__ __forceinline__ unsigned pk2(float lo, float hi) { return pg8::cvt_pk_bf16(lo, hi); }
__device__ __forceinline__ float wave_sum(float v) {
#pragma unroll
    for (int o = 1; o < 64; o <<= 1) v += __shfl_xor(v, o);
    return v;
}

typedef __attribute__((address_space(1))) unsigned gu32;
#define RLX_AGENT __ATOMIC_RELAXED, __HIP_MEMORY_SCOPE_AGENT
#define XB_TMO      128
#define XB_XCNT(j)  (256  + 64 * (j))
#define XB_XSUB(j)  (1280 + 64 * (j))
#define XB_XGEN(j)  (2304 + 64 * (j))
#define XB_TOP      3328
#define XB_TOPGEN   3392
#define XCD_BAR_WORDS 3456
#define XB_SPIN_CAP (1u << 18)

__device__ __forceinline__ unsigned xb_ld(unsigned* p)              { return __hip_atomic_load(p, __ATOMIC_RELAXED, __HIP_MEMORY_SCOPE_AGENT); }
__device__ __forceinline__ unsigned xb_add(unsigned* p, unsigned v) { return __hip_atomic_fetch_add(p, v, __ATOMIC_RELAXED, __HIP_MEMORY_SCOPE_AGENT); }
__device__ __forceinline__ unsigned xb_xcc_id() { return (unsigned)__builtin_amdgcn_s_getreg((3 << 11) | 20) & 0xFu; }
#define XB_SPIN(cond, bar) do { unsigned _sp = 0; while (cond) { __builtin_amdgcn_s_sleep(1); \
    if ((++_sp & 255u) == 0u) { if (xb_ld(&(bar)[XB_TMO])) break; if (_sp > XB_SPIN_CAP) { atomicAdd(&(bar)[XB_TMO], 1u); break; } } } } while (0)

struct XcdBarrier {
    unsigned* bar; unsigned x;
    volatile LAS unsigned* st;
};

__device__ __forceinline__ XcdBarrier xcd_barrier_post(unsigned* bar, volatile LAS unsigned* st) {
    XcdBarrier b; b.bar = bar; b.x = xb_xcc_id(); b.st = st;
    if (threadIdx.x == 0) (void)xb_add(&bar[XB_XCNT(b.x)], 1u);
    return b;
}
__device__ __forceinline__ void xcd_barrier_complete(unsigned* bar, unsigned x, unsigned& nloc, unsigned& nx) {
    const unsigned G = gridDim.x * gridDim.y * gridDim.z;
    unsigned sum, cnt, mine, sp = 0u;
    for (;;) {
        sum = 0u; cnt = 0u; mine = 0u;
#pragma unroll
        for (unsigned j = 0; j < 16; ++j) { const unsigned c = xb_ld(&bar[XB_XCNT(j)]); sum += c; cnt += (c > 0u) ? 1u : 0u; mine = (j == x) ? c : mine; }
        if (sum == G) break;
        __builtin_amdgcn_s_sleep(1);
        if ((++sp & 255u) == 0u) { if (xb_ld(&bar[XB_TMO])) break; if (sp > XB_SPIN_CAP) { atomicAdd(&bar[XB_TMO], 1u); break; } }
    }
    nloc = mine > 0u ? mine : 1u; nx = cnt > 0u ? cnt : 1u;
}

__device__ __forceinline__ void xcd_barrier(const XcdBarrier& b) {
    asm volatile("s_waitcnt vmcnt(0)" ::: "memory");
    __syncthreads();
    if (threadIdx.x == 0) {
        unsigned* bar = b.bar;
        __builtin_amdgcn_s_waitcnt(0);
        unsigned nloc = b.st[0], nx = b.st[1];
        if (nloc == 0u) { xcd_barrier_complete(bar, b.x, nloc, nx); b.st[0] = nloc; b.st[1] = nx; }
        const unsigned old = xb_add(&bar[XB_XSUB(b.x)], 1u);
        const unsigned gen = old / nloc;
        if (old + 1u == (gen + 1u) * nloc) {
            __builtin_amdgcn_fence(__ATOMIC_RELEASE, "agent");
            asm volatile("s_waitcnt vmcnt(0)" ::: "memory");
            const unsigned og = xb_add(&bar[XB_TOP], 1u);
            const unsigned tg = og / nx;
            if (og + 1u == (tg + 1u) * nx) xb_add(&bar[XB_TOPGEN], 1u);
            else XB_SPIN(xb_ld(&bar[XB_TOPGEN]) == tg, bar);
            __builtin_amdgcn_fence(__ATOMIC_ACQUIRE, "agent");
            xb_add(&bar[XB_XGEN(b.x)], 1u);
            asm volatile("s_waitcnt vmcnt(0)" ::: "memory");
        } else {
            XB_SPIN(xb_ld(&bar[XB_XGEN(b.x)]) == gen, bar);
            __builtin_amdgcn_fence(__ATOMIC_ACQUIRE, "agent");
            asm volatile("s_waitcnt vmcnt(0)" ::: "memory");
        }
    }
    __syncthreads();
}

__device__ __forceinline__ void tr_item(const float* W, int ldw, int srccol0, const float* g, bf16* Bt, int ldb, int dstrow0, int k0, int koff, LAS float* scr, int lane) {
    float tv[32]; const float* Wp = W + (size_t)(k0 + (lane >> 5)) * ldw + srccol0 + (lane & 31);
#pragma unroll
    for (int i = 0; i < 32; ++i) tv[i] = Wp[(size_t)(2 * i) * ldw];
    __builtin_amdgcn_sched_barrier(0);
#pragma unroll
    for (int i = 0; i < 32; ++i) { const int kk = 2 * i + (lane >> 5); float v = tv[i]; if (g) v *= g[k0 + kk]; scr[kk * 33 + (lane & 31)] = v; }
    LDS_WAIT(); asm volatile("" ::: "memory");
    const int c = lane & 7;
#pragma unroll
    for (int j = 0; j < 4; ++j) { const int n = (lane >> 3) + 8 * j; const LAS float* s = scr + (8 * c) * 33 + n;
        v4u o; o.x = pk2(s[0 * 33], s[1 * 33]); o.y = pk2(s[2 * 33], s[3 * 33]); o.z = pk2(s[4 * 33], s[5 * 33]); o.w = pk2(s[6 * 33], s[7 * 33]);
        *(v4u*)(Bt + (size_t)(dstrow0 + n) * ldb + koff + k0 + 8 * c) = o; }
    LDS_WAIT(); asm volatile("" ::: "memory");
}
__device__ __forceinline__ void fold_item(const float* L, int ldl, int kl0, const float* sc, const float* R, int J, bf16* Bt, int kd0, int n0, int lane) {
    float acc[8];
#pragma unroll
    for (int i = 0; i < 8; ++i) acc[i] = 0.f;
    const float* Lp = L + (size_t)kl0 * ldl; const float* Rp = R + n0 + lane;
#pragma unroll 1
    for (int j = 0; j < J; j += 16) { float wv[16];
#pragma unroll
        for (int u = 0; u < 16; ++u) wv[u] = Rp[(size_t)(j + u) * 1024];
        __builtin_amdgcn_sched_barrier(0);
#pragma unroll
        for (int u = 0; u < 16; ++u) { const float w = sc ? wv[u] * sc[j + u] : wv[u];
#pragma unroll
            for (int i = 0; i < 8; ++i) acc[i] += Lp[i * ldl + j + u] * w; } }
    v4u o; o.x = pk2(acc[0], acc[1]); o.y = pk2(acc[2], acc[3]); o.z = pk2(acc[4], acc[5]); o.w = pk2(acc[6], acc[7]);
    *(v4u*)(Bt + (size_t)(n0 + lane) * 1024 + kd0) = o;
}

struct Args { const float* in[22]; float* out; unsigned char* ws; };
constexpr int I_GU = 16 * 176, I_D = 44 * 32, I_WIN = 16 * 56, I_WV = 16 * 16, I_WO = 8 * 32, I_FOLD = 1024;
constexpr int I_LAYER = 2 * I_GU + 2 * I_D + I_WIN + I_WV + I_WO + I_FOLD;

__device__ __forceinline__ void prologue(const Args& a, LAS unsigned char* lds, int gw, int NGW, int wave, int lane) {
    LAS float* scr = (LAS float*)(lds + wave * 16384);
    unsigned char* ws = a.ws;
    for (int it = gw; it < NLAYER * I_LAYER; it += NGW) {
        const int l = it / I_LAYER; int r = it % I_LAYER;
        unsigned char* wl = ws + WS_W + (size_t)l * W_LAYER;
        if (r < 2 * I_GU) {
            const int f = r / I_GU; r %= I_GU; const int kb = r / 176, nb = r % 176, cc = 32 * nb, pn = cc >> 8, bj = (cc >> 7) & 1, j = cc & 127;
            const float* Wg = a.in[f ? 19 : 2] + (size_t)l * DM * DFF; const float* Wu = a.in[f ? 20 : 3] + (size_t)l * DM * DFF; const float* g = a.in[f ? 18 : 1] + l * DM;
            tr_item(bj ? Wu : Wg, DFF, 128 * pn + j, g, (bf16*)(wl + (f ? WO_GU2 : WO_GU1)), DM, cc, 64 * kb, 0, scr, lane); continue; }
        r -= 2 * I_GU;
        if (r < 2 * I_D) { const int f = r / I_D; r %= I_D; const int kb = r / 32, nb = r % 32;
            tr_item(a.in[f ? 21 : 4] + (size_t)l * DFF * DM, DM, 32 * nb, nullptr, (bf16*)(wl + (f ? WO_D2 : WO_D1)), DFF, 32 * nb, 64 * kb, 0, scr, lane); continue; }
        r -= 2 * I_D;
        if (r < I_WIN) { const int kb = r / 56, nb = r % 56, cc = 32 * nb; int src;
            if (cc < 512) { const int pn = cc >> 8, bj = (cc >> 7) & 1, j = cc & 127; src = (bj ? 256 : 0) + 128 * pn + j; }
            else if (cc < 768) src = cc;
            else { const int t = cc - 768, which = t >> 9, t2 = t & 511, pn2 = t2 >> 8, bj = (t2 >> 7) & 1, wc = (t2 >> 5) & 3; src = 768 + which * 512 + 256 * pn2 + 64 * wc + 32 * bj; }
            tr_item(a.in[6] + (size_t)l * DM * INW, INW, src, a.in[5] + l * DM, (bf16*)(wl + WO_WIN), DM, cc, 64 * kb, 0, scr, lane); continue; }
        r -= I_WIN;
        if (r < I_WV) { const int kb = r / 16, nb = r % 16;
            tr_item(a.in[6] + (size_t)l * DM * INW, INW, 1792 + 32 * nb, a.in[5] + l * DM, (bf16*)(wl + WO_WV), DM, 32 * nb, 64 * kb, 0, scr, lane); continue; }
        r -= I_WV;
        const float* wout = a.in[17] + (size_t)l * DM * DM;
        if (r < I_WO) { const int kb = r / 32, nb = r % 32;
            tr_item(wout + (size_t)512 * DM, DM, 32 * nb, nullptr, (bf16*)(wl + WO_WO), DM, 32 * nb, 64 * kb, 512, scr, lane); continue; }
        r -= I_WO;
        { const int kg = r / 16, nb = r % 16, k0 = 8 * kg;
            if (k0 < 256) fold_item(a.in[11] + (size_t)l * 65536, 256, k0, nullptr, wout, 256, (bf16*)(wl + WO_WO), k0, 64 * nb, lane);
            else { const int gi = (k0 - 256) >> 6, c0 = (k0 - 256) & 63;
                fold_item(a.in[12] + (size_t)l * 16384 + gi * 4096, 64, c0, a.in[13] + l * 256 + 64 * gi, wout + (size_t)(256 + 64 * gi) * DM, 64, (bf16*)(wl + WO_WO), k0, 64 * nb, lane); } }
    }
    const float* x = a.in[0]; bf16* XB = (bf16*)(ws + WS_XB); float* SS = (float*)(ws + WS_SS);
    for (int m0 = gw * 4; m0 < MTOK; m0 += NGW * 4) {
        f32x4 v[4][4];
#pragma unroll
        for (int q = 0; q < 4; ++q) { const f32x4* xr = (const f32x4*)(x + (size_t)(m0 + q) * DM) + lane;
#pragma unroll
            for (int j = 0; j < 4; ++j) v[q][j] = xr[64 * j]; }
        __builtin_amdgcn_sched_barrier(0);
#pragma unroll
        for (int q = 0; q < 4; ++q) { float s = 0.f;
#pragma unroll
            for (int j = 0; j < 4; ++j) s += (v[q][j].x * v[q][j].x + v[q][j].y * v[q][j].y) + (v[q][j].z * v[q][j].z + v[q][j].w * v[q][j].w);
            s = wave_sum(s);
            v2u* o8 = (v2u*)(XB + (size_t)(m0 + q) * DM) + lane;
#pragma unroll
            for (int j = 0; j < 4; ++j) { v2u w; w.x = pk2(v[q][j].x, v[q][j].y); w.y = pk2(v[q][j].z, v[q][j].w); o8[64 * j] = w; }
            if (lane == 0) SS[m0 + q] = s; }
    }
    for (int i = gw * 64 + lane; i < 5 * MTOK; i += NGW * 64) SS[MTOK + i] = 0.f;
}

#define SCHED_FENCE() __builtin_amdgcn_sched_barrier(0)
__device__ __forceinline__ void attn_unit(int b, int h, int r, int cb, const bf16* Q, const bf16* K, const bf16* VT, const LAS float* rpbs, bf16* Z, int lane) {
    const int fr = lane & 15, fq = lane >> 4;
    const int r0 = min(max(r - 4, 0), 56), kstart = min(max(16 * cb - 8, 0), 32), qcol = 16 * cb + fr, c0 = min(max(qcol - 8, 0), 48);
    const size_t tokb = (size_t)b * SEQ;
    const bf16* qp = Q + (tokb + r * 64 + qcol) * 512 + h * 64 + 8 * fq;
    const bf16x8 q0 = *(const bf16x8*)qp, q1 = *(const bf16x8*)(qp + 32);
    const int g0 = kstart >> 3;
    const char* kb = (const char*)(K + ((size_t)((b * 8 + h) * 64 + r0) * 4096 + g0 * 128));
    const unsigned koff = (unsigned)(fr * 64 + fq * 16);
    bf16x8 kf[8][2][2];
#pragma unroll
    for (int i = 0; i < 8; ++i)
#pragma unroll
        for (int t = 0; t < 2; ++t)
#pragma unroll
            for (int ks = 0; ks < 2; ++ks) kf[i][t][ks] = *(const bf16x8*)(kb + (size_t)(i * 8192 + (t * 2 + ks) * 2048) + koff);
    SCHED_FENCE();
    f32x4 s[8][2];
#pragma unroll
    for (int i = 0; i < 8; ++i)
#pragma unroll
        for (int t = 0; t < 2; ++t) { f32x4 c = (f32x4){0.f, 0.f, 0.f, 0.f};
            c = __builtin_amdgcn_mfma_f32_16x16x32_bf16(kf[i][t][0], q0, c, 0, 0, 0); c = __builtin_amdgcn_mfma_f32_16x16x32_bf16(kf[i][t][1], q1, c, 0, 0, 0); s[i][t] = c; }
    SCHED_FENCE();
    const char* vb = (const char*)(VT + ((size_t)((b * 8 + h) * 64 + r0) * 4096 + g0 * 128));
    const unsigned voff = (unsigned)(fq * 256 + fr * 16);
    bf16x8 vf[8][4];
#pragma unroll
    for (int i = 0; i < 8; ++i)
#pragma unroll
        for (int jd = 0; jd < 4; ++jd) vf[i][jd] = *(const bf16x8*)(vb + (size_t)(i * 8192 + jd * 2048) + voff);
    SCHED_FENCE();
    float negm[8];
#pragma unroll
    for (int j = 0; j < 8; ++j) { const int kc = kstart + 8 * fq + j; negm[j] = ((kc >= c0) && (kc < c0 + 16)) ? 0.f : -1.0e30f; }
    float mx = -3.0e38f;
    const LAS float* bp0 = rpbs + (h * 15 + (r0 - r + 7)) * 64 + (kstart + 8 * fq - qcol + 15 + 16);
#pragma unroll
    for (int i = 0; i < 8; ++i) { float bv[8];
#pragma unroll
        for (int j = 0; j < 8; ++j) bv[j] = bp0[i * 64 + j];
#pragma unroll
        for (int t = 0; t < 2; ++t)
#pragma unroll
            for (int e = 0; e < 4; ++e) { const int j = 4 * t + e; const float v = (s[i][t][e] + bv[j]) + negm[j]; s[i][t][e] = v; mx = fmaxf(mx, v); } }
    mx = fmaxf(mx, __shfl_xor(mx, 16)); mx = fmaxf(mx, __shfl_xor(mx, 32));
    float l = 0.f; bf16x8 pb[8];
#pragma unroll
    for (int i = 0; i < 8; ++i) { float p[8];
#pragma unroll
        for (int t = 0; t < 2; ++t)
#pragma unroll
            for (int e = 0; e < 4; ++e) { const float pv = __expf(s[i][t][e] - mx); p[4 * t + e] = pv; l += pv; }
        v4u w; w.x = pk2(p[0], p[1]); w.y = pk2(p[2], p[3]); w.z = pk2(p[4], p[5]); w.w = pk2(p[6], p[7]);
        pb[i] = __builtin_bit_cast(bf16x8, w); }
    l += __shfl_xor(l, 16); l += __shfl_xor(l, 32);
    SCHED_FENCE();
    f32x4 o[4];
#pragma unroll
    for (int jd = 0; jd < 4; ++jd) o[jd] = (f32x4){0.f, 0.f, 0.f, 0.f};
#pragma unroll
    for (int i = 0; i < 8; ++i)
#pragma unroll
        for (int jd = 0; jd < 4; ++jd) o[jd] = __builtin_amdgcn_mfma_f32_16x16x32_bf16(vf[i][jd], pb[i], o[jd], 0, 0, 0);
    const float il = 1.0f / l;
    bf16* zp = Z + (tokb + r * 64 + qcol) * 1024 + 512 + h * 64 + 16 * fq;
    v4u w0, w1;
    w0.x = pk2(o[0][0] * il, o[0][1] * il); w0.y = pk2(o[0][2] * il, o[0][3] * il); w0.z = pk2(o[1][0] * il, o[1][1] * il); w0.w = pk2(o[1][2] * il, o[1][3] * il);
    w1.x = pk2(o[2][0] * il, o[2][1] * il); w1.y = pk2(o[2][2] * il, o[2][3] * il); w1.z = pk2(o[3][0] * il, o[3][1] * il); w1.w = pk2(o[3][2] * il, o[3][3] * il);
    *(v4u*)zp = w0; *(v4u*)(zp + 8) = w1;
    SCHED_FENCE();
}
__device__ __forceinline__ void conv_load(const bf16* cp, int tb, unsigned short (&raw)[38]) {
#pragma unroll
    for (int j = 0; j < 38; ++j) raw[j] = cp[(ptrdiff_t)(tb - 15) * 256 + j * 256];
}
__device__ __forceinline__ void conv_item(int item, const bf16* CU, const float* dw, const float* dwb, const float* lng, const float* lnb, bf16* Z, LAS float* st, int tid) {
    const int b = item >> 6, t0 = (item & 63) * 64, c = tid & 255, half = tid >> 8, lane = tid & 63, wave = tid >> 6;
    const bf16* cp = CU + (size_t)b * SEQ * 256 + c;
    unsigned short raw[38], rawn[38];
    conv_load(cp, t0 + half * 32, raw);
    float w[31];
#pragma unroll
    for (int k = 0; k < 31; ++k) w[k] = dw[k * 256 + c];
    const float bias = dwb[c];
#pragma unroll
    for (int ch = 0; ch < 4; ++ch) { const int tb = t0 + half * 32 + ch * 8;
        if (ch < 3) conv_load(cp, tb + 8, rawn);
        SCHED_FENCE();
        float in[38];
#pragma unroll
        for (int j = 0; j < 38; ++j) { const int tt = tb - 15 + j; in[j] = (tt >= 0 && tt < SEQ) ? bf2f(raw[j]) : 0.f; }
#pragma unroll
        for (int o = 0; o < 8; ++o) { float acc = bias;
#pragma unroll
            for (int k = 0; k < 31; ++k) acc += w[k] * in[o + k];
            st[(half * 32 + ch * 8 + o) * 256 + c] = acc; }
        SCHED_FENCE();
        if (ch < 3) {
#pragma unroll
            for (int j = 0; j < 38; ++j) raw[j] = rawn[j]; } }
    __syncthreads();
    const f32x4 g4 = *(const f32x4*)(lng + 4 * lane), b4 = *(const f32x4*)(lnb + 4 * lane);
    f32x4 v[8];
#pragma unroll
    for (int tt = 0; tt < 8; ++tt) v[tt] = *(const LAS f32x4*)(st + (8 * wave + tt) * 256 + 4 * lane);
#pragma unroll
    for (int tt = 0; tt < 8; ++tt) { const int tok = 8 * wave + tt;
        const float mean = wave_sum((v[tt].x + v[tt].y) + (v[tt].z + v[tt].w)) * (1.0f / 256.0f); const f32x4 d = v[tt] - mean;
        const float var = wave_sum((d.x * d.x + d.y * d.y) + (d.z * d.z + d.w * d.w)) * (1.0f / 256.0f); const float rstd = rsqrtf(var + EPS);
        f32x4 y = d * rstd * g4 + b4;
        y.x *= pg8::fsigmoid(y.x); y.y *= pg8::fsigmoid(y.y); y.z *= pg8::fsigmoid(y.z); y.w *= pg8::fsigmoid(y.w);
        v2u o; o.x = pk2(y.x, y.y); o.y = pk2(y.z, y.w);
        *(v2u*)(Z + ((size_t)b * SEQ + t0 + tok) * 1024 + 4 * lane) = o; }
    __syncthreads();
}
template <int W> __device__ __forceinline__ void pool_compute(const float (&in)[48], int tb, bf16* zp) {
#pragma unroll
    for (int o = 0; o < 32; ++o) { float sum = 0.f;
#pragma unroll
        for (int k = 0; k < W; ++k) sum += in[o + 8 - W / 2 + k];
        const int t = tb + o, lo = max(t - W / 2, 0), hi = min(t - W / 2 + W, SEQ);
        const float mixed = sum / (float)(hi - lo) - in[o + 8];
        zp[(size_t)o * 1024] = (bf16)(pk2(mixed, 0.f) & 0xffffu); }
}
__device__ __forceinline__ void pool_item(int item, const bf16* P, bf16* Z, int tid) {
    const int b = item >> 6, t0 = (item & 63) * 64, c = tid & 255, half = tid >> 8, g = __builtin_amdgcn_readfirstlane(c >> 6), tb = t0 + half * 32;
    const bf16* pc = P + (size_t)b * SEQ * 256 + c;
    unsigned short raw[48];
#pragma unroll
    for (int j = 0; j < 48; ++j) raw[j] = pc[(ptrdiff_t)(tb - 8) * 256 + j * 256];
    SCHED_FENCE();
    float in[48];
#pragma unroll
    for (int j = 0; j < 48; ++j) { const int tt = tb - 8 + j; in[j] = (tt >= 0 && tt < SEQ) ? bf2f(raw[j]) : 0.f; }
    bf16* zp = Z + ((size_t)b * SEQ + tb) * 1024 + 256 + c;
    if (g == 0) pool_compute<2>(in, tb, zp); else if (g == 1) pool_compute<4>(in, tb, zp); else if (g == 2) pool_compute<8>(in, tb, zp); else pool_compute<16>(in, tb, zp);
    SCHED_FENCE();
}

__global__ void __launch_bounds__(512, 2) fwd_megakernel(Args a) {
    extern __shared__ __attribute__((aligned(16))) unsigned char lds_raw[];
    LAS unsigned char* lds = (LAS unsigned char*)lds_raw;
    cg::grid_group grid = cg::this_grid();
    const int tid = threadIdx.x, lane = tid & 63, wave = __builtin_amdgcn_readfirstlane(tid >> 6);
    const int G = gridDim.x, bid = blockIdx.x;
    const int vcu = (G % 8 == 0) ? (bid % 8) * (G / 8) + bid / 8 : bid;
    unsigned char* ws = a.ws;
    float* SS = (float*)(ws + WS_SS); bf16* XB = (bf16*)(ws + WS_XB); bf16* H = (bf16*)(ws + WS_H); bf16* Z = (bf16*)(ws + WS_Z);
    bf16 *CU = (bf16*)(ws + WS_CU), *P = (bf16*)(ws + WS_P), *Qb = (bf16*)(ws + WS_Q), *Kb = (bf16*)(ws + WS_K), *VT = (bf16*)(ws + WS_VT);

    { volatile LAS unsigned* misc = (volatile LAS unsigned*)(lds + MISC_OFF); if (tid < 16) misc[tid] = 0u; }
    __syncthreads();
    XcdBarrier bar = xcd_barrier_post((unsigned*)(ws + WS_CTL) + CW_BAR, (volatile LAS unsigned*)(lds + MISC_OFF));
#ifndef REP_PRO
#define REP_PRO 1
#endif
#ifndef REP_MIX
#define REP_MIX 1
#endif
#ifndef REP_G1
#define REP_G1 1
#endif
#ifndef REP_G3
#define REP_G3 1
#endif
#ifndef REP_SYNC
#define REP_SYNC 1
#endif
#pragma unroll 1
    for (int rep = 0; rep < REP_PRO; ++rep) { prologue(a, lds, vcu * 8 + wave, G * 8, wave, lane); __syncthreads(); }
    grid.sync();

#pragma unroll 1
    for (int step = 0; step < 2 * NLAYER; ++step) {
        const int l = step >> 1, f = step & 1;
        unsigned char* wl = ws + WS_W + (size_t)l * W_LAYER;
        if (f == 1) {
            const float* ssm = SS + (size_t)(3 * l + 1) * MTOK;
#pragma unroll 1
            for (int rep = 0; rep < REP_G3; ++rep) {
            { pg8::Gemm g{XB, (const bf16*)(wl + WO_WIN), MTOK, NWIN, DM}; pg8::StaticOrder S; S.init(MTOK, NWIN, G, bid);
              pg8::EpiWin E{CU, P, Qb, Kb, ssm, a.in[14] + l * 64, a.in[15] + l * 64};
              pg8::gemm_phase<pg8::EpiWin, pg8::StaticOrder, true, true>(lds, g, S, E); }
            { pg8::Gemm g{(const bf16*)(wl + WO_WV), XB, 512, MTOK, DM}; pg8::StaticOrder S; S.init(512, MTOK, G, bid);
              pg8::EpiVT E{VT, ssm, MTOK};
              pg8::gemm_phase<pg8::EpiVT, pg8::StaticOrder, true, true>(lds, g, S, E); }
            }
#pragma unroll 1
            for (int rep = 0; rep < REP_SYNC; ++rep) xcd_barrier(bar);
#pragma unroll 1
            for (int rep = 0; rep < REP_MIX; ++rep) {
                int mt_ = threadIdx.x; asm volatile("" : "+v"(mt_));
                const int tid = mt_, lane = tid & 63, wave = __builtin_amdgcn_readfirstlane(tid >> 6);
                LAS float* rpbs = (LAS float*)(lds + RPB_OFF);
                const float* rpb = a.in[16] + (size_t)l * 3720;
                for (int i = tid; i < 8 * 15 * 64; i += 512) { const int dc = (i & 63) - 16; rpbs[i] = (dc >= 0 && dc < 31) ? rpb[(i >> 6) * 31 + dc] : 0.f; }
                __syncthreads();
                const int a0 = (int)((long)vcu * 2048 / G), a1 = (int)((long)(vcu + 1) * 2048 / G);
#ifndef REP_ATT
#define REP_ATT 1
#endif
#ifndef REP_CP
#define REP_CP 1
#endif
#pragma unroll 1
                for (int rep2 = 0; rep2 < REP_ATT; ++rep2)
                for (int it = a0; it < a1; ++it) { const int bh = it >> 5, rp = it & 31;
                    attn_unit(bh >> 3, bh & 7, 2 * rp + (wave >> 2), wave & 3, Qb, Kb, VT, rpbs, Z, lane); }
                __syncthreads();
                const int c0i = (int)((long)vcu * 512 / G), c1i = (int)((long)(vcu + 1) * 512 / G);
#pragma unroll 1
                for (int rep2 = 0; rep2 < REP_CP; ++rep2) {
                for (int it = c0i; it < c1i; ++it)
                    conv_item(it, CU, a.in[7] + (size_t)l * 31 * 256, a.in[8] + l * 256, a.in[9] + l * 256, a.in[10] + l * 256, Z, (LAS float*)lds, tid);
                for (int it = c0i; it < c1i; ++it) pool_item(it, P, Z, tid);
                }
                __syncthreads();
            }
            xcd_barrier(bar);
            { pg8::Gemm g{Z, (const bf16*)(wl + WO_WO), MTOK, DM, DM}; pg8::StaticOrder S; S.init(MTOK, DM, G, bid);
              pg8::EpiResid E{a.out, a.out, XB, SS + (size_t)(3 * l + 2) * MTOK, 1.0f};
              pg8::gemm_phase<pg8::EpiResid, pg8::StaticOrder, true, true>(lds, g, S, E); }
            xcd_barrier(bar);
        }
#pragma unroll 1
        for (int rep = 0; rep < REP_G1; ++rep)
        { pg8::Gemm g{XB, (const bf16*)(wl + (f ? WO_GU2 : WO_GU1)), MTOK, NGU, DM}; pg8::StaticOrder S; S.init(MTOK, NGU, G, bid);
          pg8::EpiSwiglu E{H, DFF, SS + (size_t)(3 * l + (f ? 2 : 0)) * MTOK};
          pg8::gemm_phase<pg8::EpiSwiglu, pg8::StaticOrder, true, true>(lds, g, S, E); }
        xcd_barrier(bar);
        { pg8::Gemm g{H, (const bf16*)(wl + (f ? WO_D2 : WO_D1)), MTOK, DM, DFF}; pg8::StaticOrder S; S.init(MTOK, DM, G, bid);
          const bool last = (step == 2 * NLAYER - 1);
          pg8::EpiResid E{step == 0 ? a.in[0] : a.out, a.out, XB, last ? nullptr : SS + (size_t)(f ? 3 * (l + 1) : 3 * l + 1) * MTOK, 0.5f};
          pg8::gemm_phase<pg8::EpiResid, pg8::StaticOrder, true, true>(lds, g, S, E); }
        if (step != 2 * NLAYER - 1) xcd_barrier(bar);
    }
}

extern "C" void kernel_launch(void* const* d_in, const int* in_sizes, int n_in, void* d_out, int out_size, void* d_ws, size_t ws_size, hipStream_t stream) {
    static int grid = 0;
    if (grid == 0) {
        if (n_in != 22 || in_sizes[0] != MTOK * DM || out_size != MTOK * DM || ws_size < WS_END) { fprintf(stderr, "kernel_launch: unexpected shapes (n_in %d, in0 %d, out %d, ws %zu); nothing launched\n", n_in, n_in > 0 ? in_sizes[0] : -1, out_size, ws_size); grid = -1; return; }
        int dev = 0, cus = 0, per_cu = 0;
        if (hipGetDevice(&dev) != hipSuccess || hipDeviceGetAttribute(&cus, hipDeviceAttributeMultiprocessorCount, dev) != hipSuccess) { grid = -1; return; }
        if (hipFuncSetAttribute((const void*)fwd_megakernel, hipFuncAttributeMaxDynamicSharedMemorySize, LDS_BYTES) != hipSuccess) { fprintf(stderr, "kernel_launch: hipFuncSetAttribute failed\n"); grid = -1; return; }
        if (hipOccupancyMaxActiveBlocksPerMultiprocessor(&per_cu, (const void*)fwd_megakernel, 512, LDS_BYTES) != hipSuccess || per_cu < 1) { fprintf(stderr, "kernel_launch: occupancy query gave %d\n", per_cu); (void)hipGetLastError(); per_cu = 1; }
        grid = cus * 1;
    }
    if (grid < 0) return;
    if (hipMemsetAsync((char*)d_ws + WS_CTL, 0, CTL_ZERO_BYTES, stream) != hipSuccess) { fprintf(stderr, "kernel_launch: hipMemsetAsync failed\n"); return; }
    Args a{};
    for (int i = 0; i < 22; ++i) a.in[i] = (const float*)d_in[i];
    a.out = (float*)d_out; a.ws = (unsigned char*)d_ws;
    void* args[] = {&a};
    hipError_t e = hipLaunchCooperativeKernel((const void*)fwd_megakernel, dim3(grid), dim3(512), args, LDS_BYTES, stream);
    if (e != hipSuccess) fprintf(stderr, "kernel_launch: cooperative launch failed: %s (grid %d)\n", hipGetErrorString(e), grid);
}
```

```cpp
#include <hip/hip_runtime.h>
#include <hip/hip_cooperative_groups.h>
#include <cstdio>
#include <cstdint>
namespace cg = cooperative_groups;
namespace pg8 {
#define PG8_LAS __attribute__((address_space(3)))
typedef unsigned short bf16_t;
typedef short bf16x8 __attribute__((ext_vector_type(8)));
typedef float f32x4 __attribute__((ext_vector_type(4)));
typedef unsigned u32x4 __attribute__((ext_vector_type(4)));
constexpr int BM = 256, BK = 64, HALF = 128, HTB = HALF * BK * 2  , STAGE_BYTES = 8 * HTB, NXCD = 8, WGM = 8;

__host__ __device__ __forceinline__ int lds_byte(int r, int c) { const int st = (r >> 4) * 2 + (c >> 5), rr = r & 15, cc = c & 31, ob = rr * 64 + cc * 2; return st * 1024 + (ob ^ (((ob >> 9) & 1) << 5)); }
__host__ __device__ __forceinline__ void stage_rc(int b, int& R, int& C) { const int st = b / 1024, sb = b % 1024, swz = sb ^ (((sb >> 9) & 1) << 5); R = (st >> 1) * 16 + swz / 64; C = (st & 1) * 32 + (swz % 64) / 2; }
__host__ __device__ __forceinline__ int perm32(int rho) { const int n = rho >> 4, i = rho & 15; return 8 * (i >> 2) + 4 * n + (i & 3); }

struct Unit { int pm, pn; };
struct Gemm { const bf16_t* A; const bf16_t* Bt; int M, N, K; };

struct StaticOrder {
    int nM, nN, nwg, G, c;
    __host__ __device__ void init(int M, int N, int G_, int c_) { nM = M / BM; nN = N / BM; nwg = nM * nN; G = G_; c = c_; }
    __host__ __device__ bool next(int i, Unit& u) const {
        const long L = (long)i * G + c; if (L >= nwg) return false;
        int wgid = (int)L; { const int q = nwg / NXCD, r = nwg % NXCD, xcd = wgid % NXCD, off = wgid / NXCD; wgid = (xcd < r ? xcd * (q + 1) : r * (q + 1) + (xcd - r) * q) + off; }
        const int nig = WGM * nN, gid = wgid / nig, fm = gid * WGM, gsz = (nM - fm) < WGM ? (nM - fm) : WGM;
        u.pm = fm + ((wgid % nig) % gsz); u.pn = (wgid % nig) / gsz; return true;
    }
    __device__ __forceinline__ void a_ready(const Unit&) const {}
    __device__ __forceinline__ void done(const Unit&) const {}
};

__device__ __forceinline__ unsigned cvt_pk_bf16(float lo, float hi) { unsigned r; asm volatile("v_cvt_pk_bf16_f32 %0, %1, %2" : "=v"(r) : "v"(lo), "v"(hi)); return r; }
typedef float f32x2 __attribute__((ext_vector_type(2)));
constexpr float NORM_EPS = 1e-6f;
__device__ __forceinline__ float fsigmoid(float x) { return __builtin_amdgcn_rcpf(1.0f + __expf(-x)); }
__device__ __forceinline__ float row_rstd(const float* ss, int row) { return rsqrtf(ss[row] * (1.0f / 1024.0f) + NORM_EPS); }

struct EpiSwiglu {
    static constexpr bool PERM = true, AFTER_DRAIN = false;
    bf16_t* H; int ldh; const float* ss;
    __device__ __forceinline__ void operator()(const f32x4 (&acc)[2][2][4][2], const Unit& u, int wr, int wc, int fr, int fq) const {
        const int row0 = u.pm * BM + wr * 64 + fr, col0 = u.pn * HALF + wc * 32 + 8 * fq;
#ifndef REP_EPI
#define REP_EPI 1
#endif
#if REP_EPI > 1
#pragma unroll 1
        for (int rep = 0; rep < REP_EPI; ++rep)
#endif
#pragma unroll
        for (int ai = 0; ai < 2; ++ai)
#pragma unroll
            for (int m = 0; m < 4; ++m) { const int row = row0 + ai * HALF + m * 16; const float rs = row_rstd(ss, row);
                float h[8];
#pragma unroll
                for (int n = 0; n < 2; ++n)
#pragma unroll
                    for (int e = 0; e < 4; ++e) { const float g = acc[ai][0][m][n][e] * rs, up = acc[ai][1][m][n][e] * rs; h[4 * n + e] = g * fsigmoid(g) * up; }
                u32x4 w; w.x = cvt_pk_bf16(h[0], h[1]); w.y = cvt_pk_bf16(h[2], h[3]); w.z = cvt_pk_bf16(h[4], h[5]); w.w = cvt_pk_bf16(h[6], h[7]);
                *(u32x4*)(H + (size_t)row * ldh + col0) = w; }
    }
};
struct EpiResid {
    static constexpr bool PERM = true, AFTER_DRAIN = false;
    const float* base32; float* out32; bf16_t* xb; float* ssn; float alpha;
    __device__ __forceinline__ void operator()(const f32x4 (&acc)[2][2][4][2], const Unit& u, int wr, int wc, int fr, int fq) const {
        const int row0 = u.pm * BM + wr * 64 + fr, col0 = u.pn * BM + wc * 32 + 8 * fq;
#pragma unroll
        for (int ai = 0; ai < 2; ++ai)
#pragma unroll
            for (int m = 0; m < 4; ++m) { const int row = row0 + ai * HALF + m * 16; float part = 0.f;
#pragma unroll
                for (int bj = 0; bj < 2; ++bj) { const size_t off = (size_t)row * 1024 + col0 + bj * HALF;
                    f32x4 b0, b1;
                    if (base32) { b0 = *(const f32x4*)(base32 + off); b1 = *(const f32x4*)(base32 + off + 4); }
                    else { const u32x4 r = *(const u32x4*)(xb + off);
                        b0 = (f32x4){__uint_as_float(r.x << 16), __uint_as_float(r.x & 0xffff0000u), __uint_as_float(r.y << 16), __uint_as_float(r.y & 0xffff0000u)};
                        b1 = (f32x4){__uint_as_float(r.z << 16), __uint_as_float(r.z & 0xffff0000u), __uint_as_float(r.w << 16), __uint_as_float(r.w & 0xffff0000u)}; }
                    const f32x4 o0 = b0 + acc[ai][bj][m][0] * alpha, o1 = b1 + acc[ai][bj][m][1] * alpha;
                    if (out32) { *(f32x4*)(out32 + off) = o0; *(f32x4*)(out32 + off + 4) = o1; }
                    else { u32x4 w; w.x = cvt_pk_bf16(o0[0], o0[1]); w.y = cvt_pk_bf16(o0[2], o0[3]); w.z = cvt_pk_bf16(o1[0], o1[1]); w.w = cvt_pk_bf16(o1[2], o1[3]);
                        *(u32x4*)(xb + off) = w;
                        part += (o0[0] * o0[0] + o0[1] * o0[1]) + (o0[2] * o0[2] + o0[3] * o0[3]) + (o1[0] * o1[0] + o1[1] * o1[1]) + (o1[2] * o1[2] + o1[3] * o1[3]); } }
                if (!out32) { part += __shfl_xor(part, 16); part += __shfl_xor(part, 32); if (fq == 0) unsafeAtomicAdd(ssn + row, part); } }
    }
};
struct EpiWin {
    static constexpr bool PERM = true, AFTER_DRAIN = false;
    bf16_t *CU, *P, *Q, *Kq; const float* ss; const float *qg, *kg;
    __device__ __forceinline__ void operator()(const f32x4 (&acc)[2][2][4][2], const Unit& u, int wr, int wc, int fr, int fq) const {
        const int row0 = u.pm * BM + wr * 64 + fr, pn = u.pn;
        if (pn < 2) {
#pragma unroll
            for (int ai = 0; ai < 2; ++ai)
#pragma unroll
                for (int m = 0; m < 4; ++m) { const int row = row0 + ai * HALF + m * 16; const float rs = row_rstd(ss, row); float h[8];
#pragma unroll
                    for (int n = 0; n < 2; ++n)
#pragma unroll
                        for (int e = 0; e < 4; ++e) { const float a = acc[ai][0][m][n][e] * rs, g = acc[ai][1][m][n][e] * rs; h[4 * n + e] = a * fsigmoid(g); }
                    u32x4 w; w.x = cvt_pk_bf16(h[0], h[1]); w.y = cvt_pk_bf16(h[2], h[3]); w.z = cvt_pk_bf16(h[4], h[5]); w.w = cvt_pk_bf16(h[6], h[7]);
                    *(u32x4*)(CU + (size_t)row * 256 + pn * HALF + wc * 32 + 8 * fq) = w; }
        } else if (pn == 2) {
#pragma unroll
            for (int ai = 0; ai < 2; ++ai)
#pragma unroll
                for (int m = 0; m < 4; ++m) { const int row = row0 + ai * HALF + m * 16; const float rs = row_rstd(ss, row);
#pragma unroll
                    for (int bj = 0; bj < 2; ++bj) { const f32x4 v0 = acc[ai][bj][m][0] * rs, v1 = acc[ai][bj][m][1] * rs;
                        u32x4 w; w.x = cvt_pk_bf16(v0[0], v0[1]); w.y = cvt_pk_bf16(v0[2], v0[3]); w.z = cvt_pk_bf16(v1[0], v1[1]); w.w = cvt_pk_bf16(v1[2], v1[3]);
                        *(u32x4*)(P + (size_t)row * 256 + bj * HALF + wc * 32 + 8 * fq) = w; } }
        } else {
            const int which = (pn - 3) >> 1, head = 4 * ((pn - 3) & 1) + wc;
            const float* gp = (which ? kg : qg) + 8 * fq; const float post = which ? 1.0f : 0.125f;
            f32x4 gv[2][2];
#pragma unroll
            for (int bj = 0; bj < 2; ++bj)
#pragma unroll
                for (int n = 0; n < 2; ++n) gv[bj][n] = *(const f32x4*)(gp + 32 * bj + 4 * n) * post;
            bf16_t* dst = Q + head * 64 + 8 * fq;
#pragma unroll
            for (int ai = 0; ai < 2; ++ai)
#pragma unroll
                for (int m = 0; m < 4; ++m) { const int row = row0 + ai * HALF + m * 16; const float rs = row_rstd(ss, row);
                    f32x4 v[2][2]; float q = 0.f;
#pragma unroll
                    for (int bj = 0; bj < 2; ++bj)
#pragma unroll
                        for (int n = 0; n < 2; ++n) { v[bj][n] = acc[ai][bj][m][n] * rs; const f32x4 x = v[bj][n]; q += (x[0] * x[0] + x[1] * x[1]) + (x[2] * x[2] + x[3] * x[3]); }
                    q += __shfl_xor(q, 16); q += __shfl_xor(q, 32);
                    const float r2 = rsqrtf(q * (1.0f / 64.0f) + NORM_EPS);
#pragma unroll
                    for (int bj = 0; bj < 2; ++bj) { const f32x4 v0 = v[bj][0] * gv[bj][0] * r2, v1 = v[bj][1] * gv[bj][1] * r2;
                        u32x4 w; w.x = cvt_pk_bf16(v0[0], v0[1]); w.y = cvt_pk_bf16(v0[2], v0[3]); w.z = cvt_pk_bf16(v1[0], v1[1]); w.w = cvt_pk_bf16(v1[2], v1[3]);
                        if (which) { const int tb_ = row >> 12, ts_ = row & 4095, gr = ts_ >> 6, col = ts_ & 63;
                            *(u32x4*)(Kq + ((size_t)((tb_ * 8 + head) * 64 + gr) * 4096 + ((((col >> 2) & 1) * 2 + bj) * 8 + (col >> 3)) * 128 + (col & 3) * 32 + fq * 8)) = w; }
                        else *(u32x4*)(dst + (size_t)row * 512 + 32 * bj) = w; } }
        }
    }
};
struct EpiVT {
    static constexpr bool PERM = true, AFTER_DRAIN = false;
    bf16_t* VT; const float* ss; int ldv;
    __device__ __forceinline__ void operator()(const f32x4 (&acc)[2][2][4][2], const Unit& u, int wr, int wc, int fr, int fq) const {
        const int row0 = u.pm * BM + wr * 64 + fr, col0 = u.pn * BM + wc * 32 + 8 * fq;
        f32x4 rsv[2][2];
#pragma unroll
        for (int bj = 0; bj < 2; ++bj)
#pragma unroll
            for (int n = 0; n < 2; ++n) { const f32x4 s4 = *(const f32x4*)(ss + col0 + bj * HALF + 4 * n);
                rsv[bj][n] = (f32x4){rsqrtf(s4[0] * (1.0f / 1024.0f) + NORM_EPS), rsqrtf(s4[1] * (1.0f / 1024.0f) + NORM_EPS), rsqrtf(s4[2] * (1.0f / 1024.0f) + NORM_EPS), rsqrtf(s4[3] * (1.0f / 1024.0f) + NORM_EPS)}; }
#pragma unroll
        for (int ai = 0; ai < 2; ++ai)
#pragma unroll
            for (int m = 0; m < 4; ++m) { const int dim = row0 + ai * HALF + m * 16, hh = dim >> 6, d = dim & 63, jd = (d >> 2) & 3, frv = 4 * (d >> 4) + (d & 3);
#pragma unroll
                for (int bj = 0; bj < 2; ++bj) { const f32x4 v0 = acc[ai][bj][m][0] * rsv[bj][0], v1 = acc[ai][bj][m][1] * rsv[bj][1];
                    u32x4 w; w.x = cvt_pk_bf16(v0[0], v0[1]); w.y = cvt_pk_bf16(v0[2], v0[3]); w.z = cvt_pk_bf16(v1[0], v1[1]); w.w = cvt_pk_bf16(v1[2], v1[3]);
                    const int tok = col0 + bj * HALF, tb_ = tok >> 12, ts_ = tok & 4095, gr = ts_ >> 6, col = ts_ & 63;
                    *(u32x4*)(VT + ((size_t)((tb_ * 8 + hh) * 64 + gr) * 4096 + (jd * 8 + (col >> 3)) * 128 + frv * 8)) = w; } }
    }
};
template <class Epi, class Sched, bool ALIGN_EPI = false, bool SP2 = false>
__device__ __forceinline__ void gemm_phase(PG8_LAS unsigned char* lds, const Gemm g, const Sched& S, const Epi& E) {
    int tid_ = threadIdx.x; asm volatile("" : "+v"(tid_));
    const int tid = tid_, wid = __builtin_amdgcn_readfirstlane(tid >> 6), lane = tid & 63, wr = wid >> 2, wc = wid & 3, fr = lane & 15, fq = lane >> 4;
    const int K = g.K, nt = K / BK;
    unsigned voffA[2], voffB[2];
#pragma unroll
    for (int i = 0; i < 2; ++i) { int R, C; stage_rc(tid * 16 + i * 8192, R, C); const int Rb = Epi::PERM ? ((R & ~31) + perm32(R & 31)) : R;
        voffA[i] = (unsigned)(R * K + C) * 2u; voffB[i] = (unsigned)(Rb * K + C) * 2u; }
    const size_t kstep = (size_t)(BK * 2);
    const size_t hstep = (size_t)HALF * K * 2;
    const size_t tstep = 2 * hstep;
    const unsigned ldsw = (unsigned)wid * 1024u;
    const int aoff = lds_byte(wr * 64 + fr, fq * 8), boff = lds_byte(wc * 32 + fr, fq * 8);
#define PG8_SA(b, h) (((b) * 2 + (h)) * HTB)
#define PG8_SB(b, h) ((4 + (b) * 2 + (h)) * HTB)
#define PG8_STAGE(bufoff, gbase, voff) do { _Pragma("unroll") for (int _i = 0; _i < 2; ++_i) \
        __builtin_amdgcn_global_load_lds((const unsigned*)((const char*)(gbase) + (voff)[_i]), (PG8_LAS unsigned*)(lds + (bufoff) + ldsw + _i * 8192), 16, 0, 0); } while (0)
#define PG8_LDA(dst, b, h) do { _Pragma("unroll") for (int m = 0; m < 4; ++m) _Pragma("unroll") for (int k = 0; k < 2; ++k) dst[m][k] = *(const PG8_LAS bf16x8*)(lds + PG8_SA(b, h) + aoff + m * 2048 + k * 1024); } while (0)
#define PG8_LDB(dst, b, h) do { _Pragma("unroll") for (int n = 0; n < 2; ++n) _Pragma("unroll") for (int k = 0; k < 2; ++k) dst[n][k] = *(const PG8_LAS bf16x8*)(lds + PG8_SB(b, h) + boff + n * 2048 + k * 1024); } while (0)
#define PG8_MMA(ai, bj, At, Bt) do { __builtin_amdgcn_s_setprio(1); _Pragma("unroll") for (int m = 0; m < 4; ++m) _Pragma("unroll") for (int n = 0; n < 2; ++n) _Pragma("unroll") for (int k = 0; k < 2; ++k) \
        acc[ai][bj][m][n] = __builtin_amdgcn_mfma_f32_16x16x32_bf16(Bt[n][k], At[m][k], acc[ai][bj][m][n], 0, 0, 0); __builtin_amdgcn_s_setprio(0); } while (0)
#define PG8_WAIT_V(n) asm volatile("s_waitcnt vmcnt(" #n ")" ::: "memory")
#define PG8_WAIT_L(n) asm volatile("s_waitcnt lgkmcnt(" #n ")" ::: "memory")
#define PG8_BAR __builtin_amdgcn_s_barrier()
#define PG8_SCHED __builtin_amdgcn_sched_barrier(0)
    Unit cur, nxt; int ui = 0;
    if (!S.next(0, cur)) return;
    f32x4 acc[2][2][4][2];
#pragma unroll
    for (int a = 0; a < 2; ++a)
#pragma unroll
        for (int b = 0; b < 2; ++b)
#pragma unroll
            for (int m = 0; m < 4; ++m)
#pragma unroll
                for (int n = 0; n < 2; ++n) acc[a][b][m][n] = (f32x4){0.f, 0.f, 0.f, 0.f};
    bf16x8 At[4][2], B0[2][2], B1[2][2];
    const char* cA = (const char*)g.A + (size_t)cur.pm * tstep; const char* cB = (const char*)g.Bt + (size_t)cur.pn * tstep;
    S.a_ready(cur);
    if constexpr (SP2) {
        PG8_STAGE(PG8_SB(0, 0), cB, voffB); PG8_STAGE(PG8_SB(0, 1), cB + hstep, voffB); PG8_STAGE(PG8_SA(0, 0), cA, voffA); PG8_STAGE(PG8_SA(0, 1), cA + hstep, voffA);
        if (wr == 1) PG8_BAR;
        PG8_WAIT_V(2); PG8_BAR;
        PG8_STAGE(PG8_SB(1, 0), cB + kstep, voffB); PG8_STAGE(PG8_SA(1, 0), cA + kstep, voffA); PG8_STAGE(PG8_SB(1, 1), cB + hstep + kstep, voffB);
        PG8_WAIT_V(6); PG8_BAR;
    } else {
        PG8_STAGE(PG8_SB(0, 0), cB, voffB); PG8_STAGE(PG8_SA(0, 0), cA, voffA); PG8_STAGE(PG8_SB(0, 1), cB + hstep, voffB); PG8_STAGE(PG8_SA(0, 1), cA + hstep, voffA);
        if (wr == 1) PG8_BAR;
        PG8_WAIT_V(4); PG8_BAR;
        PG8_STAGE(PG8_SB(1, 0), cB + kstep, voffB); PG8_STAGE(PG8_SA(1, 0), cA + kstep, voffA); PG8_STAGE(PG8_SB(1, 1), cB + hstep + kstep, voffB);
        PG8_WAIT_V(6); PG8_BAR;
    }
    for (;;) {
        const bool has_next = S.next(ui + 1, nxt);
        const char* nA = has_next ? (const char*)g.A + (size_t)nxt.pm * tstep : cA; const char* nB = has_next ? (const char*)g.Bt + (size_t)nxt.pn * tstep : cB;
        for (int t = 0; t < nt; t += 2) {
            const bool last = (t == nt - 2);
            const char* a1 = cA + (size_t)(t + 1) * kstep;
            const char* a2 = last ? nA : cA + (size_t)(t + 2) * kstep; const char* b2 = last ? nB : cB + (size_t)(t + 2) * kstep;
            const char* a3 = a2 + kstep; const char* b3 = b2 + kstep;
            if (last && has_next) S.a_ready(nxt);
            if constexpr (SP2) {
            PG8_LDB(B0, 0, 0); PG8_LDB(B1, 0, 1); PG8_SCHED; PG8_LDA(At, 0, 0); PG8_STAGE(PG8_SA(1, 1), a1 + hstep, voffA);
            PG8_WAIT_V(8); PG8_WAIT_L(0); PG8_BAR; PG8_MMA(0, 0, At, B0); PG8_MMA(0, 1, At, B1); PG8_BAR; PG8_SCHED;
            PG8_LDA(At, 0, 1); PG8_STAGE(PG8_SB(0, 0), b2, voffB); PG8_STAGE(PG8_SB(0, 1), b2 + hstep, voffB); PG8_STAGE(PG8_SA(0, 0), a2, voffA);
            PG8_WAIT_V(8); PG8_WAIT_L(0); PG8_BAR; PG8_MMA(1, 0, At, B0); PG8_MMA(1, 1, At, B1); PG8_BAR; PG8_SCHED;
            PG8_LDB(B0, 1, 0); PG8_LDB(B1, 1, 1); PG8_SCHED; PG8_LDA(At, 1, 0); PG8_STAGE(PG8_SA(0, 1), a2 + hstep, voffA);
            PG8_WAIT_V(8); PG8_WAIT_L(0); PG8_BAR; PG8_MMA(0, 0, At, B0); PG8_MMA(0, 1, At, B1); PG8_BAR; PG8_SCHED;
            PG8_LDA(At, 1, 1); PG8_STAGE(PG8_SB(1, 0), b3, voffB); PG8_STAGE(PG8_SB(1, 1), b3 + hstep, voffB); PG8_STAGE(PG8_SA(1, 0), a3, voffA);
            PG8_WAIT_V(8); PG8_WAIT_L(0); PG8_BAR; PG8_MMA(1, 0, At, B0); PG8_MMA(1, 1, At, B1); PG8_BAR; PG8_SCHED;
            } else {
            PG8_LDB(B0, 0, 0); PG8_SCHED; PG8_LDA(At, 0, 0); PG8_STAGE(PG8_SA(1, 1), a1 + hstep, voffA);
            PG8_WAIT_L(8); PG8_BAR; PG8_WAIT_L(0); PG8_MMA(0, 0, At, B0); PG8_BAR; PG8_SCHED;
            PG8_LDB(B1, 0, 1); PG8_STAGE(PG8_SB(0, 0), b2, voffB);
            PG8_BAR; PG8_WAIT_L(0); PG8_MMA(0, 1, At, B1); PG8_BAR;
            PG8_LDA(At, 0, 1); PG8_STAGE(PG8_SA(0, 0), a2, voffA);
            PG8_BAR; PG8_WAIT_L(0); PG8_MMA(1, 0, At, B0); PG8_BAR; PG8_SCHED;
            PG8_STAGE(PG8_SB(0, 1), b2 + hstep, voffB);
            PG8_WAIT_V(6); PG8_BAR; PG8_MMA(1, 1, At, B1); PG8_BAR;
            PG8_LDB(B0, 1, 0); PG8_SCHED; PG8_LDA(At, 1, 0); PG8_STAGE(PG8_SA(0, 1), a2 + hstep, voffA);
            PG8_WAIT_L(8); PG8_BAR; PG8_WAIT_L(0); PG8_MMA(0, 0, At, B0); PG8_BAR; PG8_SCHED;
            PG8_LDB(B1, 1, 1); PG8_STAGE(PG8_SB(1, 0), b3, voffB);
            PG8_BAR; PG8_WAIT_L(0); PG8_MMA(0, 1, At, B1); PG8_BAR;
            PG8_LDA(At, 1, 1); PG8_STAGE(PG8_SA(1, 0), a3, voffA);
            PG8_BAR; PG8_WAIT_L(0); PG8_MMA(1, 0, At, B0); PG8_BAR; PG8_SCHED;
            PG8_STAGE(PG8_SB(1, 1), b3 + hstep, voffB);
            PG8_WAIT_V(6); PG8_BAR; PG8_MMA(1, 1, At, B1); PG8_BAR;
            }
        }
        if constexpr (ALIGN_EPI) { if (wr == 0) PG8_BAR; }
        if constexpr (!Epi::AFTER_DRAIN) { E(acc, cur, wr, wc, fr, fq); S.done(cur); }
        if (!has_next) break;
#pragma unroll
        for (int a = 0; a < 2; ++a)
#pragma unroll
            for (int b = 0; b < 2; ++b)
#pragma unroll
                for (int m = 0; m < 4; ++m)
#pragma unroll
                    for (int n = 0; n < 2; ++n) acc[a][b][m][n] = (f32x4){0.f, 0.f, 0.f, 0.f};
        cur = nxt; cA = nA; cB = nB; ++ui;
        if constexpr (ALIGN_EPI) { if (wr == 1) PG8_BAR; }
    }
    PG8_WAIT_V(0);
    if constexpr (!ALIGN_EPI) { if (wr == 0) PG8_BAR; }
    PG8_BAR;
    if constexpr (Epi::AFTER_DRAIN) { E.fused(acc, cur, wr, wc, fr, fq, lds, wid, lane); S.done(cur); }
#undef PG8_SA
#undef PG8_SB
#undef PG8_STAGE
#undef PG8_LDA
#undef PG8_LDB
#undef PG8_MMA
#undef PG8_WAIT_V
#undef PG8_WAIT_L
#undef PG8_BAR
#undef PG8_SCHED
}
}

constexpr int DM = 1024, NB = 8, SEQ = 4096, MTOK = NB * SEQ, DFF = 2816, INW = 2304, NLAYER = 2, NHEAD = 8;
constexpr int NGU = 2 * DFF;
constexpr int NWIN = 1792;
constexpr float EPS = 1e-6f;
constexpr size_t MiB = 1u << 20;
constexpr size_t WS_CTL = 0, CTL_ZERO_BYTES = 65536; constexpr int CW_BAR = 4096;
constexpr size_t WS_SS = 1 * MiB;
constexpr size_t WS_W = 2 * MiB, W_LAYER = 40 * MiB;
constexpr size_t WO_GU1 = 0, WO_D1 = 11 * MiB, WO_WIN = WO_D1 + 5632 * 1024, WO_WV = WO_WIN + 3584 * 1024, WO_WO = WO_WV + 1 * MiB, WO_GU2 = WO_WO + 2 * MiB, WO_D2 = WO_GU2 + 11 * MiB;
static_assert(WO_D2 + 5632 * 1024 <= W_LAYER, "weights per layer");
constexpr size_t WS_XB = 82 * MiB;
constexpr size_t WS_H = 146 * MiB;
constexpr size_t WS_CU = WS_H, WS_P = WS_CU + 16 * MiB, WS_Q = WS_P + 16 * MiB, WS_K = WS_Q + 32 * MiB, WS_VT = WS_K + 32 * MiB;
constexpr size_t WS_Z = 322 * MiB, WS_END = 386 * MiB;
static_assert(WS_VT + 32 * MiB <= WS_Z && WS_W + 2 * W_LAYER <= WS_XB, "d_ws map");
constexpr int LDS_BYTES = 131072 + 30720 + 64;
constexpr int RPB_OFF = 131072, MISC_OFF = 131072 + 30720;

#define LAS __attribute__((address_space(3)))
typedef unsigned short bf16;
typedef unsigned v4u __attribute__((ext_vector_type(4)));
typedef unsigned v2u __attribute__((ext_vector_type(2)));
typedef float f32x4 __attribute__((ext_vector_type(4)));
typedef short bf16x8 __attribute__((ext_vector_type(8)));
#define LDS_WAIT() asm volatile("s_waitcnt lgkmcnt(0)" ::: "memory")
__device__ __forceinline__ float bf2f(unsigned short v) { return __uint_as_float((unsigned)v << 16); }
__device__ __forceinline__ unsigned pk2(float lo, float hi) { return pg8::cvt_pk_bf16(lo, hi); }
__device__ __forceinline__ float wave_sum(float v) {
#pragma unroll
    for (int o = 1; o < 64; o <<= 1) v += __shfl_xor(v, o);
    return v;
}

typedef __attribute__((address_space(1))) unsigned gu32;
#define RLX_AGENT __ATOMIC_RELAXED, __HIP_MEMORY_SCOPE_AGENT
#define XB_TMO      128
#define XB_XCNT(j)  (256  + 64 * (j))
#define XB_XSUB(j)  (1280 + 64 * (j))
#define XB_XGEN(j)  (2304 + 64 * (j))
#define XB_TOP      3328
#define XB_TOPGEN   3392
#define XCD_BAR_WORDS 3456
#define XB_SPIN_CAP (1u << 18)

__device__ __forceinline__ unsigned xb_ld(unsigned* p)              { return __hip_atomic_load(p, __ATOMIC_RELAXED, __HIP_MEMORY_SCOPE_AGENT); }
__device__ __forceinline__ unsigned xb_add(unsigned* p, unsigned v) { return __hip_atomic_fetch_add(p, v, __ATOMIC_RELAXED, __HIP_MEMORY_SCOPE_AGENT); }
__device__ __forceinline__ unsigned xb_xcc_id() { return (unsigned)__builtin_amdgcn_s_getreg((3 << 11) | 20) & 0xFu; }
#define XB_SPIN(cond, bar) do { unsigned _sp = 0; while (cond) { __builtin_amdgcn_s_sleep(1); \
    if ((++_sp & 255u) == 0u) { if (xb_ld(&(bar)[XB_TMO])) break; if (_sp > XB_SPIN_CAP) { atomicAdd(&(bar)[XB_TMO], 1u); break; } } } } while (0)

struct XcdBarrier {
    unsigned* bar; unsigned x;
    volatile LAS unsigned* st;
};

__device__ __forceinline__ XcdBarrier xcd_barrier_post(unsigned* bar, volatile LAS unsigned* st) {
    XcdBarrier b; b.bar = bar; b.x = xb_xcc_id(); b.st = st;
    if (threadIdx.x == 0) (void)xb_add(&bar[XB_XCNT(b.x)], 1u);
    return b;
}
__device__ __forceinline__ void xcd_barrier_complete(unsigned* bar, unsigned x, unsigned& nloc, unsigned& nx) {
    const unsigned G = gridDim.x * gridDim.y * gridDim.z;
    unsigned sum, cnt, mine, sp = 0u;
    for (;;) {
        sum = 0u; cnt = 0u; mine = 0u;
#pragma unroll
        for (unsigned j = 0; j < 16; ++j) { const unsigned c = xb_ld(&bar[XB_XCNT(j)]); sum += c; cnt += (c > 0u) ? 1u : 0u; mine = (j == x) ? c : mine; }
        if (sum == G) break;
        __builtin_amdgcn_s_sleep(1);
        if ((++sp & 255u) == 0u) { if (xb_ld(&bar[XB_TMO])) break; if (sp > XB_SPIN_CAP) { atomicAdd(&bar[XB_TMO], 1u); break; } }
    }
    nloc = mine > 0u ? mine : 1u; nx = cnt > 0u ? cnt : 1u;
}

__device__ __forceinline__ void xcd_barrier(const XcdBarrier& b) {
    asm volatile("s_waitcnt vmcnt(0)" ::: "memory");
    __syncthreads();
    if (threadIdx.x == 0) {
        unsigned* bar = b.bar;
        __builtin_amdgcn_s_waitcnt(0);
        unsigned nloc = b.st[0], nx = b.st[1];
        if (nloc == 0u) { xcd_barrier_complete(bar, b.x, nloc, nx); b.st[0] = nloc; b.st[1] = nx; }
        const unsigned old = xb_add(&bar[XB_XSUB(b.x)], 1u);
        const unsigned gen = old / nloc;
        if (old + 1u == (gen + 1u) * nloc) {
            __builtin_amdgcn_fence(__ATOMIC_RELEASE, "agent");
            asm volatile("s_waitcnt vmcnt(0)" ::: "memory");
            const unsigned og = xb_add(&bar[XB_TOP], 1u);
            const unsigned tg = og / nx;
            if (og + 1u == (tg + 1u) * nx) xb_add(&bar[XB_TOPGEN], 1u);
            else XB_SPIN(xb_ld(&bar[XB_TOPGEN]) == tg, bar);
            __builtin_amdgcn_fence(__ATOMIC_ACQUIRE, "agent");
            xb_add(&bar[XB_XGEN(b.x)], 1u);
            asm volatile("s_waitcnt vmcnt(0)" ::: "memory");
        } else {
            XB_SPIN(xb_ld(&bar[XB_XGEN(b.x)]) == gen, bar);
            __builtin_amdgcn_fence(__ATOMIC_ACQUIRE, "agent");
            asm volatile("s_waitcnt vmcnt(0)" ::: "memory");
        }
    }
    __syncthreads();
}

__device__ __forceinline__ void tr_item(const float* W, int ldw, int srccol0, const float* g, bf16* Bt, int ldb, int dstrow0, int k0, int koff, LAS float* scr, int lane) {
    float tv[32]; const float* Wp = W + (size_t)(k0 + (lane >> 5)) * ldw + srccol0 + (lane & 31);
#pragma unroll
    for (int i = 0; i < 32; ++i) tv[i] = Wp[(size_t)(2 * i) * ldw];
    __builtin_amdgcn_sched_barrier(0);
#pragma unroll
    for (int i = 0; i < 32; ++i) { const int kk = 2 * i + (lane >> 5); float v = tv[i]; if (g) v *= g[k0 + kk]; scr[kk * 33 + (lane & 31)] = v; }
    LDS_WAIT(); asm volatile("" ::: "memory");
    const int c = lane & 7;
#pragma unroll
    for (int j = 0; j < 4; ++j) { const int n = (lane >> 3) + 8 * j; const LAS float* s = scr + (8 * c) * 33 + n;
        v4u o; o.x = pk2(s[0 * 33], s[1 * 33]); o.y = pk2(s[2 * 33], s[3 * 33]); o.z = pk2(s[4 * 33], s[5 * 33]); o.w = pk2(s[6 * 33], s[7 * 33]);
        *(v4u*)(Bt + (size_t)(dstrow0 + n) * ldb + koff + k0 + 8 * c) = o; }
    LDS_WAIT(); asm volatile("" ::: "memory");
}
__device__ __forceinline__ void fold_item(const float* L, int ldl, int kl0, const float* sc, const float* R, int J, bf16* Bt, int kd0, int n0, int lane) {
    float acc[8];
#pragma unroll
    for (int i = 0; i < 8; ++i) acc[i] = 0.f;
    const float* Lp = L + (size_t)kl0 * ldl; const float* Rp = R + n0 + lane;
#pragma unroll 1
    for (int j = 0; j < J; j += 16) { float wv[16];
#pragma unroll
        for (int u = 0; u < 16; ++u) wv[u] = Rp[(size_t)(j + u) * 1024];
        __builtin_amdgcn_sched_barrier(0);
#pragma unroll
        for (int u = 0; u < 16; ++u) { const float w = sc ? wv[u] * sc[j + u] : wv[u];
#pragma unroll
            for (int i = 0; i < 8; ++i) acc[i] += Lp[i * ldl + j + u] * w; } }
    v4u o; o.x = pk2(acc[0], acc[1]); o.y = pk2(acc[2], acc[3]); o.z = pk2(acc[4], acc[5]); o.w = pk2(acc[6], acc[7]);
    *(v4u*)(Bt + (size_t)(n0 + lane) * 1024 + kd0) = o;
}

struct Args { const float* in[22]; float* out; unsigned char* ws; };
constexpr int I_GU = 16 * 176, I_D = 44 * 32, I_WIN = 16 * 56, I_WV = 16 * 16, I_WO = 8 * 32, I_FOLD = 1024;
constexpr int I_LAYER = 2 * I_GU + 2 * I_D + I_WIN + I_WV + I_WO + I_FOLD;

__device__ __forceinline__ void prologue(const Args& a, LAS unsigned char* lds, int gw, int NGW, int wave, int lane) {
    LAS float* scr = (LAS float*)(lds + wave * 16384);
    unsigned char* ws = a.ws;
    for (int it = gw; it < NLAYER * I_LAYER; it += NGW) {
        const int l = it / I_LAYER; int r = it % I_LAYER;
        unsigned char* wl = ws + WS_W + (size_t)l * W_LAYER;
        if (r < 2 * I_GU) {
            const int f = r / I_GU; r %= I_GU; const int kb = r / 176, nb = r % 176, cc = 32 * nb, pn = cc >> 8, bj = (cc >> 7) & 1, j = cc & 127;
            const float* Wg = a.in[f ? 19 : 2] + (size_t)l * DM * DFF; const float* Wu = a.in[f ? 20 : 3] + (size_t)l * DM * DFF; const float* g = a.in[f ? 18 : 1] + l * DM;
            tr_item(bj ? Wu : Wg, DFF, 128 * pn + j, g, (bf16*)(wl + (f ? WO_GU2 : WO_GU1)), DM, cc, 64 * kb, 0, scr, lane); continue; }
        r -= 2 * I_GU;
        if (r < 2 * I_D) { const int f = r / I_D; r %= I_D; const int kb = r / 32, nb = r % 32;
            tr_item(a.in[f ? 21 : 4] + (size_t)l * DFF * DM, DM, 32 * nb, nullptr, (bf16*)(wl + (f ? WO_D2 : WO_D1)), DFF, 32 * nb, 64 * kb, 0, scr, lane); continue; }
        r -= 2 * I_D;
        if (r < I_WIN) { const int kb = r / 56, nb = r % 56, cc = 32 * nb; int src;
            if (cc < 512) { const int pn = cc >> 8, bj = (cc >> 7) & 1, j = cc & 127; src = (bj ? 256 : 0) + 128 * pn + j; }
            else if (cc < 768) src = cc;
            else { const int t = cc - 768, which = t >> 9, t2 = t & 511, pn2 = t2 >> 8, bj = (t2 >> 7) & 1, wc = (t2 >> 5) & 3; src = 768 + which * 512 + 256 * pn2 + 64 * wc + 32 * bj; }
            tr_item(a.in[6] + (size_t)l * DM * INW, INW, src, a.in[5] + l * DM, (bf16*)(wl + WO_WIN), DM, cc, 64 * kb, 0, scr, lane); continue; }
        r -= I_WIN;
        if (r < I_WV) { const int kb = r / 16, nb = r % 16;
            tr_item(a.in[6] + (size_t)l * DM * INW, INW, 1792 + 32 * nb, a.in[5] + l * DM, (bf16*)(wl + WO_WV), DM, 32 * nb, 64 * kb, 0, scr, lane); continue; }
        r -= I_WV;
        const float* wout = a.in[17] + (size_t)l * DM * DM;
        if (r < I_WO) { const int kb = r / 32, nb = r % 32;
            tr_item(wout + (size_t)512 * DM, DM, 32 * nb, nullptr, (bf16*)(wl + WO_WO), DM, 32 * nb, 64 * kb, 512, scr, lane); continue; }
        r -= I_WO;
        { const int kg = r / 16, nb = r % 16, k0 = 8 * kg;
            if (k0 < 256) fold_item(a.in[11] + (size_t)l * 65536, 256, k0, nullptr, wout, 256, (bf16*)(wl + WO_WO), k0, 64 * nb, lane);
            else { const int gi = (k0 - 256) >> 6, c0 = (k0 - 256) & 63;
                fold_item(a.in[12] + (size_t)l * 16384 + gi * 4096, 64, c0, a.in[13] + l * 256 + 64 * gi, wout + (size_t)(256 + 64 * gi) * DM, 64, (bf16*)(wl + WO_WO), k0, 64 * nb, lane); } }
    }
    const float* x = a.in[0]; bf16* XB = (bf16*)(ws + WS_XB); float* SS = (float*)(ws + WS_SS);
    for (int m0 = gw * 4; m0 < MTOK; m0 += NGW * 4) {
        f32x4 v[4][4];
#pragma unroll
        for (int q = 0; q < 4; ++q) { const f32x4* xr = (const f32x4*)(x + (size_t)(m0 + q) * DM) + lane;
#pragma unroll
            for (int j = 0; j < 4; ++j) v[q][j] = xr[64 * j]; }
        __builtin_amdgcn_sched_barrier(0);
#pragma unroll
        for (int q = 0; q < 4; ++q) { float s = 0.f;
#pragma unroll
            for (int j = 0; j < 4; ++j) s += (v[q][j].x * v[q][j].x + v[q][j].y * v[q][j].y) + (v[q][j].z * v[q][j].z + v[q][j].w * v[q][j].w);
            s = wave_sum(s);
            v2u* o8 = (v2u*)(XB + (size_t)(m0 + q) * DM) + lane;
#pragma unroll
            for (int j = 0; j < 4; ++j) { v2u w; w.x = pk2(v[q][j].x, v[q][j].y); w.y = pk2(v[q][j].z, v[q][j].w); o8[64 * j] = w; }
            if (lane == 0) SS[m0 + q] = s; }
    }
    for (int i = gw * 64 + lane; i < 5 * MTOK; i += NGW * 64) SS[MTOK + i] = 0.f;
}

#define SCHED_FENCE() __builtin_amdgcn_sched_barrier(0)
__device__ __forceinline__ void attn_unit(int b, int h, int r, int cb, const bf16* Q, const bf16* K, const bf16* VT, const LAS float* rpbs, bf16* Z, int lane) {
    const int fr = lane & 15, fq = lane >> 4;
    const int r0 = min(max(r - 4, 0), 56), kstart = min(max(16 * cb - 8, 0), 32), qcol = 16 * cb + fr, c0 = min(max(qcol - 8, 0), 48);
    const size_t tokb = (size_t)b * SEQ;
    const bf16* qp = Q + (tokb + r * 64 + qcol) * 512 + h * 64 + 8 * fq;
    const bf16x8 q0 = *(const bf16x8*)qp, q1 = *(const bf16x8*)(qp + 32);
    const int g0 = kstart >> 3;
    const char* kb = (const char*)(K + ((size_t)((b * 8 + h) * 64 + r0) * 4096 + g0 * 128));
    const unsigned koff = (unsigned)(fr * 64 + fq * 16);
    bf16x8 kf[8][2][2];
#pragma unroll
    for (int i = 0; i < 8; ++i)
#pragma unroll
        for (int t = 0; t < 2; ++t)
#pragma unroll
            for (int ks = 0; ks < 2; ++ks) kf[i][t][ks] = *(const bf16x8*)(kb + (size_t)(i * 8192 + (t * 2 + ks) * 2048) + koff);
    SCHED_FENCE();
    f32x4 s[8][2];
#pragma unroll
    for (int i = 0; i < 8; ++i)
#pragma unroll
        for (int t = 0; t < 2; ++t) { f32x4 c = (f32x4){0.f, 0.f, 0.f, 0.f};
            c = __builtin_amdgcn_mfma_f32_16x16x32_bf16(kf[i][t][0], q0, c, 0, 0, 0); c = __builtin_amdgcn_mfma_f32_16x16x32_bf16(kf[i][t][1], q1, c, 0, 0, 0); s[i][t] = c; }
    SCHED_FENCE();
    const char* vb = (const char*)(VT + ((size_t)((b * 8 + h) * 64 + r0) * 4096 + g0 * 128));
    const unsigned voff = (unsigned)(fq * 256 + fr * 16);
    bf16x8 vf[8][4];
#pragma unroll
    for (int i = 0; i < 8; ++i)
#pragma unroll
        for (int jd = 0; jd < 4; ++jd) vf[i][jd] = *(const bf16x8*)(vb + (size_t)(i * 8192 + jd * 2048) + voff);
    SCHED_FENCE();
    float negm[8];
#pragma unroll
    for (int j = 0; j < 8; ++j) { const int kc = kstart + 8 * fq + j; negm[j] = ((kc >= c0) && (kc < c0 + 16)) ? 0.f : -1.0e30f; }
    float mx = -3.0e38f;
    const LAS float* bp0 = rpbs + (h * 15 + (r0 - r + 7)) * 64 + (kstart + 8 * fq - qcol + 15 + 16);
#pragma unroll
    for (int i = 0; i < 8; ++i) { float bv[8];
#pragma unroll
        for (int j = 0; j < 8; ++j) bv[j] = bp0[i * 64 + j];
#pragma unroll
        for (int t = 0; t < 2; ++t)
#pragma unroll
            for (int e = 0; e < 4; ++e) { const int j = 4 * t + e; const float v = (s[i][t][e] + bv[j]) + negm[j]; s[i][t][e] = v; mx = fmaxf(mx, v); } }
    mx = fmaxf(mx, __shfl_xor(mx, 16)); mx = fmaxf(mx, __shfl_xor(mx, 32));
    float l = 0.f; bf16x8 pb[8];
#pragma unroll
    for (int i = 0; i < 8; ++i) { float p[8];
#pragma unroll
        for (int t = 0; t < 2; ++t)
#pragma unroll
            for (int e = 0; e < 4; ++e) { const float pv = __expf(s[i][t][e] - mx); p[4 * t + e] = pv; l += pv; }
        v4u w; w.x = pk2(p[0], p[1]); w.y = pk2(p[2], p[3]); w.z = pk2(p[4], p[5]); w.w = pk2(p[6], p[7]);
        pb[i] = __builtin_bit_cast(bf16x8, w); }
    l += __shfl_xor(l, 16); l += __shfl_xor(l, 32);
    SCHED_FENCE();
    f32x4 o[4];
#pragma unroll
    for (int jd = 0; jd < 4; ++jd) o[jd] = (f32x4){0.f, 0.f, 0.f, 0.f};
#pragma unroll
    for (int i = 0; i < 8; ++i)
#pragma unroll
        for (int jd = 0; jd < 4; ++jd) o[jd] = __builtin_amdgcn_mfma_f32_16x16x32_bf16(vf[i][jd], pb[i], o[jd], 0, 0, 0);
    const float il = 1.0f / l;
    bf16* zp = Z + (tokb + r * 64 + qcol) * 1024 + 512 + h * 64 + 16 * fq;
    v4u w0, w1;
    w0.x = pk2(o[0][0] * il, o[0][1] * il); w0.y = pk2(o[0][2] * il, o[0][3] * il); w0.z = pk2(o[1][0] * il, o[1][1] * il); w0.w = pk2(o[1][2] * il, o[1][3] * il);
    w1.x = pk2(o[2][0] * il, o[2][1] * il); w1.y = pk2(o[2][2] * il, o[2][3] * il); w1.z = pk2(o[3][0] * il, o[3][1] * il); w1.w = pk2(o[3][2] * il, o[3][3] * il);
    *(v4u*)zp = w0; *(v4u*)(zp + 8) = w1;
    SCHED_FENCE();
}
__device__ __forceinline__ void conv_load(const bf16* cp, int tb, unsigned short (&raw)[38]) {
#pragma unroll
    for (int j = 0; j < 38; ++j) raw[j] = cp[(ptrdiff_t)(tb - 15) * 256 + j * 256];
}
__device__ __forceinline__ void conv_item(int item, const bf16* CU, const float* dw, const float* dwb, const float* lng, const float* lnb, bf16* Z, LAS float* st, int tid) {
    const int b = item >> 6, t0 = (item & 63) * 64, c = tid & 255, half = tid >> 8, lane = tid & 63, wave = tid >> 6;
    const bf16* cp = CU + (size_t)b * SEQ * 256 + c;
    unsigned short raw[38], rawn[38];
    conv_load(cp, t0 + half * 32, raw);
    float w[31];
#pragma unroll
    for (int k = 0; k < 31; ++k) w[k] = dw[k * 256 + c];
    const float bias = dwb[c];
#pragma unroll
    for (int ch = 0; ch < 4; ++ch) { const int tb = t0 + half * 32 + ch * 8;
        if (ch < 3) conv_load(cp, tb + 8, rawn);
        SCHED_FENCE();
        float in[38];
#pragma unroll
        for (int j = 0; j < 38; ++j) { const int tt = tb - 15 + j; in[j] = (tt >= 0 && tt < SEQ) ? bf2f(raw[j]) : 0.f; }
#pragma unroll
        for (int o = 0; o < 8; ++o) { float acc = bias;
#pragma unroll
            for (int k = 0; k < 31; ++k) acc += w[k] * in[o + k];
            st[(half * 32 + ch * 8 + o) * 256 + c] = acc; }
        SCHED_FENCE();
        if (ch < 3) {
#pragma unroll
            for (int j = 0; j < 38; ++j) raw[j] = rawn[j]; } }
    __syncthreads();
    const f32x4 g4 = *(const f32x4*)(lng + 4 * lane), b4 = *(const f32x4*)(lnb + 4 * lane);
    f32x4 v[8];
#pragma unroll
    for (int tt = 0; tt < 8; ++tt) v[tt] = *(const LAS f32x4*)(st + (8 * wave + tt) * 256 + 4 * lane);
#pragma unroll
    for (int tt = 0; tt < 8; ++tt) { const int tok = 8 * wave + tt;
        const float mean = wave_sum((v[tt].x + v[tt].y) + (v[tt].z + v[tt].w)) * (1.0f / 256.0f); const f32x4 d = v[tt] - mean;
        const float var = wave_sum((d.x * d.x + d.y * d.y) + (d.z * d.z + d.w * d.w)) * (1.0f / 256.0f); const float rstd = rsqrtf(var + EPS);
        f32x4 y = d * rstd * g4 + b4;
        y.x *= pg8::fsigmoid(y.x); y.y *= pg8::fsigmoid(y.y); y.z *= pg8::fsigmoid(y.z); y.w *= pg8::fsigmoid(y.w);
        v2u o; o.x = pk2(y.x, y.y); o.y = pk2(y.z, y.w);
        *(v2u*)(Z + ((size_t)b * SEQ + t0 + tok) * 1024 + 4 * lane) = o; }
    __syncthreads();
}
template <int W> __device__ __forceinline__ void pool_compute(const float (&in)[48], int tb, bf16* zp) {
#pragma unroll
    for (int o = 0; o < 32; ++o) { float sum = 0.f;
#pragma unroll
        for (int k = 0; k < W; ++k) sum += in[o + 8 - W / 2 + k];
        const int t = tb + o, lo = max(t - W / 2, 0), hi = min(t - W / 2 + W, SEQ);
        const float mixed = sum / (float)(hi - lo) - in[o + 8];
        zp[(size_t)o * 1024] = (bf16)(pk2(mixed, 0.f) & 0xffffu); }
}
__device__ __forceinline__ void pool_item(int item, const bf16* P, bf16* Z, int tid) {
    const int b = item >> 6, t0 = (item & 63) * 64, c = tid & 255, half = tid >> 8, g = __builtin_amdgcn_readfirstlane(c >> 6), tb = t0 + half * 32;
    const bf16* pc = P + (size_t)b * SEQ * 256 + c;
    unsigned short raw[48];
#pragma unroll
    for (int j = 0; j < 48; ++j) raw[j] = pc[(ptrdiff_t)(tb - 8) * 256 + j * 256];
    SCHED_FENCE();
    float in[48];
#pragma unroll
    for (int j = 0; j < 48; ++j) { const int tt = tb - 8 + j; in[j] = (tt >= 0 && tt < SEQ) ? bf2f(raw[j]) : 0.f; }
    bf16* zp = Z + ((size_t)b * SEQ + tb) * 1024 + 256 + c;
    if (g == 0) pool_compute<2>(in, tb, zp); else if (g == 1) pool_compute<4>(in, tb, zp); else if (g == 2) pool_compute<8>(in, tb, zp); else pool_compute<16>(in, tb, zp);
    SCHED_FENCE();
}

__global__ void __launch_bounds__(512, 2) fwd_megakernel(Args a) {
    extern __shared__ __attribute__((aligned(16))) unsigned char lds_raw[];
    LAS unsigned char* lds = (LAS unsigned char*)lds_raw;
    cg::grid_group grid = cg::this_grid();
    const int tid = threadIdx.x, lane = tid & 63, wave = __builtin_amdgcn_readfirstlane(tid >> 6);
    const int G = gridDim.x, bid = blockIdx.x;
    const int vcu = (G % 8 == 0) ? (bid % 8) * (G / 8) + bid / 8 : bid;
    unsigned char* ws = a.ws;
    float* SS = (float*)(ws + WS_SS); bf16* XB = (bf16*)(ws + WS_XB); bf16* H = (bf16*)(ws + WS_H); bf16* Z = (bf16*)(ws + WS_Z);
    bf16 *CU = (bf16*)(ws + WS_CU), *P = (bf16*)(ws + WS_P), *Qb = (bf16*)(ws + WS_Q), *Kb = (bf16*)(ws + WS_K), *VT = (bf16*)(ws + WS_VT);

    { volatile LAS unsigned* misc = (volatile LAS unsigned*)(lds + MISC_OFF); if (tid < 16) misc[tid] = 0u; }
    __syncthreads();
    XcdBarrier bar = xcd_barrier_post((unsigned*)(ws + WS_CTL) + CW_BAR, (volatile LAS unsigned*)(lds + MISC_OFF));
#ifndef REP_PRO
#define REP_PRO 1
#endif
#ifndef REP_MIX
#define REP_MIX 1
#endif
#ifndef REP_G1
#define REP_G1 1
#endif
#ifndef REP_G3
#define REP_G3 1
#endif
#ifndef REP_SYNC
#define REP_SYNC 1
#endif
#pragma unroll 1
    for (int rep = 0; rep < REP_PRO; ++rep) { prologue(a, lds, vcu * 8 + wave, G * 8, wave, lane); __syncthreads(); }
    grid.sync();

#pragma unroll 1
    for (int step = 0; step < 2 * NLAYER; ++step) {
        const int l = step >> 1, f = step & 1;
        unsigned char* wl = ws + WS_W + (size_t)l * W_LAYER;
        if (f == 1) {
            const float* ssm = SS + (size_t)(3 * l + 1) * MTOK;
#pragma unroll 1
            for (int rep = 0; rep < REP_G3; ++rep) {
            { pg8::Gemm g{XB, (const bf16*)(wl + WO_WIN), MTOK, NWIN, DM}; pg8::StaticOrder S; S.init(MTOK, NWIN, G, bid);
              pg8::EpiWin E{CU, P, Qb, Kb, ssm, a.in[14] + l * 64, a.in[15] + l * 64};
              pg8::gemm_phase<pg8::EpiWin, pg8::StaticOrder, true, true>(lds, g, S, E); }
            { pg8::Gemm g{(const bf16*)(wl + WO_WV), XB, 512, MTOK, DM}; pg8::StaticOrder S; S.init(512, MTOK, G, bid);
              pg8::EpiVT E{VT, ssm, MTOK};
              pg8::gemm_phase<pg8::EpiVT, pg8::StaticOrder, true, true>(lds, g, S, E); }
            }
#pragma unroll 1
            for (int rep = 0; rep < REP_SYNC; ++rep) xcd_barrier(bar);
#pragma unroll 1
            for (int rep = 0; rep < REP_MIX; ++rep) {
                int mt_ = threadIdx.x; asm volatile("" : "+v"(mt_));
                const int tid = mt_, lane = tid & 63, wave = __builtin_amdgcn_readfirstlane(tid >> 6);
                LAS float* rpbs = (LAS float*)(lds + RPB_OFF);
                const float* rpb = a.in[16] + (size_t)l * 3720;
                for (int i = tid; i < 8 * 15 * 64; i += 512) { const int dc = (i & 63) - 16; rpbs[i] = (dc >= 0 && dc < 31) ? rpb[(i >> 6) * 31 + dc] : 0.f; }
                __syncthreads();
                const int a0 = (int)((long)vcu * 2048 / G), a1 = (int)((long)(vcu + 1) * 2048 / G);
#ifndef REP_ATT
#define REP_ATT 1
#endif
#ifndef REP_CP
#define REP_CP 1
#endif
#pragma unroll 1
                for (int rep2 = 0; rep2 < REP_ATT; ++rep2)
                for (int it = a0; it < a1; ++it) { const int bh = it >> 5, rp = it & 31;
                    attn_unit(bh >> 3, bh & 7, 2 * rp + (wave >> 2), wave & 3, Qb, Kb, VT, rpbs, Z, lane); }
                __syncthreads();
                const int c0i = (int)((long)vcu * 512 / G), c1i = (int)((long)(vcu + 1) * 512 / G);
#pragma unroll 1
                for (int rep2 = 0; rep2 < REP_CP; ++rep2) {
                for (int it = c0i; it < c1i; ++it)
                    conv_item(it, CU, a.in[7] + (size_t)l * 31 * 256, a.in[8] + l * 256, a.in[9] + l * 256, a.in[10] + l * 256, Z, (LAS float*)lds, tid);
                for (int it = c0i; it < c1i; ++it) pool_item(it, P, Z, tid);
                }
                __syncthreads();
            }
            xcd_barrier(bar);
            { pg8::Gemm g{Z, (const bf16*)(wl + WO_WO), MTOK, DM, DM}; pg8::StaticOrder S; S.init(MTOK, DM, G, bid);
              pg8::EpiResid E{nullptr, nullptr, XB, SS + (size_t)(3 * l + 2) * MTOK, 1.0f};
              pg8::gemm_phase<pg8::EpiResid, pg8::StaticOrder, true, true>(lds, g, S, E); }
            xcd_barrier(bar);
        }
#pragma unroll 1
        for (int rep = 0; rep < REP_G1; ++rep)
        { pg8::Gemm g{XB, (const bf16*)(wl + (f ? WO_GU2 : WO_GU1)), MTOK, NGU, DM}; pg8::StaticOrder S; S.init(MTOK, NGU, G, bid);
          pg8::EpiSwiglu E{H, DFF, SS + (size_t)(3 * l + (f ? 2 : 0)) * MTOK};
          pg8::gemm_phase<pg8::EpiSwiglu, pg8::StaticOrder, true, true>(lds, g, S, E); }
        xcd_barrier(bar);
        { pg8::Gemm g{H, (const bf16*)(wl + (f ? WO_D2 : WO_D1)), MTOK, DM, DFF}; pg8::StaticOrder S; S.init(MTOK, DM, G, bid);
          const bool last = (step == 2 * NLAYER - 1);
          pg8::EpiResid E{step == 0 ? a.in[0] : nullptr, last ? a.out : nullptr, XB, last ? nullptr : SS + (size_t)(f ? 3 * (l + 1) : 3 * l + 1) * MTOK, 0.5f};
          pg8::gemm_phase<pg8::EpiResid, pg8::StaticOrder, true, true>(lds, g, S, E); }
        if (step != 2 * NLAYER - 1) xcd_barrier(bar);
    }
}

extern "C" void kernel_launch(void* const* d_in, const int* in_sizes, int n_in, void* d_out, int out_size, void* d_ws, size_t ws_size, hipStream_t stream) {
    static int grid = 0;
    if (grid == 0) {
        if (n_in != 22 || in_sizes[0] != MTOK * DM || out_size != MTOK * DM || ws_size < WS_END) { fprintf(stderr, "kernel_launch: unexpected shapes (n_in %d, in0 %d, out %d, ws %zu); nothing launched\n", n_in, n_in > 0 ? in_sizes[0] : -1, out_size, ws_size); grid = -1; return; }
        int dev = 0, cus = 0, per_cu = 0;
        if (hipGetDevice(&dev) != hipSuccess || hipDeviceGetAttribute(&cus, hipDeviceAttributeMultiprocessorCount, dev) != hipSuccess) { grid = -1; return; }
        if (hipFuncSetAttribute((const void*)fwd_megakernel, hipFuncAttributeMaxDynamicSharedMemorySize, LDS_BYTES) != hipSuccess) { fprintf(stderr, "kernel_launch: hipFuncSetAttribute failed\n"); grid = -1; return; }
        if (hipOccupancyMaxActiveBlocksPerMultiprocessor(&per_cu, (const void*)fwd_megakernel, 512, LDS_BYTES) != hipSuccess || per_cu < 1) { fprintf(stderr, "kernel_launch: occupancy query gave %d\n", per_cu); (void)hipGetLastError(); per_cu = 1; }
        grid = cus * 1;
    }
    if (grid < 0) return;
    if (hipMemsetAsync((char*)d_ws + WS_CTL, 0, CTL_ZERO_BYTES, stream) != hipSuccess) { fprintf(stderr, "kernel_launch: hipMemsetAsync failed\n"); return; }
    Args a{};
    for (int i = 0; i < 22; ++i) a.in[i] = (const float*)d_in[i];
    a.out = (float*)d_out; a.ws = (unsigned char*)d_ws;
    void* args[] = {&a};
    hipError_t e = hipLaunchCooperativeKernel((const void*)fwd_megakernel, dim3(grid), dim3(512), args, LDS_BYTES, stream);
    if (e != hipSuccess) fprintf(stderr, "kernel_launch: cooperative launch failed: %s (grid %d)\n", hipGetErrorString(e), grid);
}
```

```cpp
#include <hip/hip_runtime.h>
#include <hip/hip_cooperative_groups.h>
#include <cstdio>
#include <cstdint>
namespace cg = cooperative_groups;
namespace pg8 {
#define PG8_LAS __attribute__((address_space(3)))
typedef unsigned short bf16_t;
typedef short bf16x8 __attribute__((ext_vector_type(8)));
typedef float f32x4 __attribute__((ext_vector_type(4)));
typedef unsigned u32x4 __attribute__((ext_vector_type(4)));
constexpr int BM = 256, BK = 64, HALF = 128, HTB = HALF * BK * 2  , STAGE_BYTES = 8 * HTB, NXCD = 8, WGM = 8;

__host__ __device__ __forceinline__ int lds_byte(int r, int c) { const int st = (r >> 4) * 2 + (c >> 5), rr = r & 15, cc = c & 31, ob = rr * 64 + cc * 2; return st * 1024 + (ob ^ (((ob >> 9) & 1) << 5)); }
__host__ __device__ __forceinline__ void stage_rc(int b, int& R, int& C) { const int st = b / 1024, sb = b % 1024, swz = sb ^ (((sb >> 9) & 1) << 5); R = (st >> 1) * 16 + swz / 64; C = (st & 1) * 32 + (swz % 64) / 2; }
__host__ __device__ __forceinline__ int perm32(int rho) { const int n = rho >> 4, i = rho & 15; return 8 * (i >> 2) + 4 * n + (i & 3); }

struct Unit { int pm, pn; };
struct Gemm { const bf16_t* A; const bf16_t* Bt; int M, N, K; int ldA; size_t kstepA, hstepA, tstepA; int ldB; size_t kstepB, hstepB, tstepB;
    __host__ __device__ static Gemm make(const bf16_t* A, bool tmA, const bf16_t* Bt, bool tmB, int M, int N, int K) {
        const size_t ks = (size_t)(BK * 2), hs = (size_t)HALF * K * 2, ts = (size_t)BM * K * 2, kst = (size_t)(BM * BK * 2), hst = (size_t)(HALF * BK * 2), tst = (size_t)(K / BK) * (BM * BK * 2);
        return Gemm{A, Bt, M, N, K, tmA ? BK : K, tmA ? kst : ks, tmA ? hst : hs, tmA ? tst : ts, tmB ? BK : K, tmB ? kst : ks, tmB ? hst : hs, tmB ? tst : ts}; } };

struct StaticOrder {
    int nM, nN, nwg, G, c, rev;
    __host__ __device__ void init(int M, int N, int G_, int c_, int rev_ = 0) { nM = M / BM; nN = N / BM; nwg = nM * nN; G = G_; c = c_; rev = rev_; }
    __host__ __device__ bool next(int i, Unit& u) const {
        const long L = (long)i * G + c; if (L >= nwg) return false;
        int wgid = (int)L; { const int q = nwg / NXCD, r = nwg % NXCD, xcd = wgid % NXCD, off = wgid / NXCD; wgid = (xcd < r ? xcd * (q + 1) : r * (q + 1) + (xcd - r) * q) + off; }
        const int nig = WGM * nN, gid = wgid / nig, fm = gid * WGM, gsz = (nM - fm) < WGM ? (nM - fm) : WGM;
        u.pm = fm + ((wgid % nig) % gsz); u.pn = (wgid % nig) / gsz; if (rev) u.pm = nM - 1 - u.pm; return true;
    }
    __device__ __forceinline__ void a_ready(const Unit&) const {}
    __device__ __forceinline__ void done(const Unit&) const {}
};

template <int NM, int NN, int W, int REV> struct GroupOrder {
    int G, c;
    __host__ __device__ void init(int G_, int c_) { G = G_; c = c_; }
    __host__ __device__ bool next(int i, Unit& u) const {
        const int wgid = i * G + c; if (wgid >= NM * NN) return false;
        constexpr int nig = W * NN; const int gid = wgid / nig, fm = gid * W, gsz = (NM - fm) < W ? (NM - fm) : W, w = wgid % nig;
        u.pm = fm + (w % gsz); u.pn = w / gsz; if (REV) u.pm = NM - 1 - u.pm; return true;
    }
    __device__ __forceinline__ void a_ready(const Unit&) const {}
    __device__ __forceinline__ void done(const Unit&) const {}
};
__device__ __forceinline__ unsigned cvt_pk_bf16(float lo, float hi) { unsigned r; asm volatile("v_cvt_pk_bf16_f32 %0, %1, %2" : "=v"(r) : "v"(lo), "v"(hi)); return r; }
typedef float f32x2 __attribute__((ext_vector_type(2)));
constexpr float NORM_EPS = 1e-6f;
__device__ __forceinline__ float fsigmoid(float x) { return __builtin_amdgcn_rcpf(1.0f + __expf(-x)); }
__device__ __forceinline__ float row_rstd(const float* ss, int row) { return rsqrtf(ss[row] * (1.0f / 1024.0f) + NORM_EPS); }

struct EpiSwiglu {
    static constexpr bool PERM = true, AFTER_DRAIN = false;
    bf16_t* H; int nkt; const float* ss;
    __device__ __forceinline__ void operator()(const f32x4 (&acc)[2][2][4][2], const Unit& u, int wr, int wc, int fr, int fq) const {
        const int row0 = u.pm * BM + wr * 64 + fr, col0 = u.pn * HALF + wc * 32 + 8 * fq;
        float rsv[2][4];
#pragma unroll
        for (int ai = 0; ai < 2; ++ai)
#pragma unroll
            for (int m = 0; m < 4; ++m) rsv[ai][m] = ss[row0 + ai * HALF + m * 16];
        __builtin_amdgcn_sched_barrier(0);
#pragma unroll
        for (int ai = 0; ai < 2; ++ai)
#pragma unroll
            for (int m = 0; m < 4; ++m) { const int row = row0 + ai * HALF + m * 16; const float rs = rsqrtf(rsv[ai][m] * (1.0f / 1024.0f) + NORM_EPS), rs2 = rs * rs, cz = rs * -1.4426950408889634f;
                unsigned w[4];
#pragma unroll
                for (int n = 0; n < 2; ++n)
#pragma unroll
                    for (int p = 0; p < 2; ++p) { const f32x2 ag = (f32x2){acc[ai][0][m][n][2 * p], acc[ai][0][m][n][2 * p + 1]}, au = (f32x2){acc[ai][1][m][n][2 * p], acc[ai][1][m][n][2 * p + 1]};
                        const f32x2 t = ag * au, z = ag * cz;
                        f32x2 d; d.x = __builtin_amdgcn_exp2f(z.x); d.y = __builtin_amdgcn_exp2f(z.y); d = d + 1.0f;
                        f32x2 r; r.x = __builtin_amdgcn_rcpf(d.x); r.y = __builtin_amdgcn_rcpf(d.y);
                        const f32x2 h = (t * rs2) * r; w[2 * n + p] = cvt_pk_bf16(h.x, h.y); }
                u32x4 wv; wv.x = w[0]; wv.y = w[1]; wv.z = w[2]; wv.w = w[3];
                *(u32x4*)(H + ((size_t)((row >> 8) * nkt + (col0 >> 6)) * 256 + (row & 255)) * 64 + (col0 & 63)) = wv; }
    }
};
struct EpiResid {
    static constexpr bool PERM = true, AFTER_DRAIN = false;
    const float* base32; float* out32; bf16_t* xb; float* ssn; float alpha;
    __device__ __forceinline__ void operator()(const f32x4 (&acc)[2][2][4][2], const Unit& u, int wr, int wc, int fr, int fq) const {
        const int row0 = u.pm * BM + wr * 64 + fr, col0 = u.pn * BM + wc * 64 + 8 * fq;
        if (base32) {
#pragma unroll
            for (int ai = 0; ai < 2; ++ai) {
                f32x4 b[4][2][2];
#pragma unroll
                for (int m = 0; m < 4; ++m)
#pragma unroll
                    for (int bj = 0; bj < 2; ++bj) { const size_t off = (size_t)(row0 + ai * HALF + m * 16) * 1024 + col0 + bj * 32; b[m][bj][0] = *(const f32x4*)(base32 + off); b[m][bj][1] = *(const f32x4*)(base32 + off + 4); }
                __builtin_amdgcn_sched_barrier(0);
#pragma unroll
                for (int m = 0; m < 4; ++m) { const int row = row0 + ai * HALF + m * 16; float part = 0.f;
#pragma unroll
                    for (int bj = 0; bj < 2; ++bj) { const size_t off = (size_t)row * 1024 + col0 + bj * 32;
                        const f32x4 o0 = b[m][bj][0] + acc[ai][bj][m][0] * alpha, o1 = b[m][bj][1] + acc[ai][bj][m][1] * alpha;
                        u32x4 w; w.x = cvt_pk_bf16(o0[0], o0[1]); w.y = cvt_pk_bf16(o0[2], o0[3]); w.z = cvt_pk_bf16(o1[0], o1[1]); w.w = cvt_pk_bf16(o1[2], o1[3]);
                        *(u32x4*)(xb + off) = w;
                        part += (o0[0] * o0[0] + o0[1] * o0[1]) + (o0[2] * o0[2] + o0[3] * o0[3]) + (o1[0] * o1[0] + o1[1] * o1[1]) + (o1[2] * o1[2] + o1[3] * o1[3]); }
                    part += __shfl_xor(part, 16); part += __shfl_xor(part, 32); if (fq == 0) unsafeAtomicAdd(ssn + row, part); }
                __builtin_amdgcn_sched_barrier(0); }
            return; }
        u32x4 r[2][4][2];
#pragma unroll
        for (int ai = 0; ai < 2; ++ai)
#pragma unroll
            for (int m = 0; m < 4; ++m)
#pragma unroll
                for (int bj = 0; bj < 2; ++bj) r[ai][m][bj] = *(const u32x4*)(xb + (size_t)(row0 + ai * HALF + m * 16) * 1024 + col0 + bj * 32);
        __builtin_amdgcn_sched_barrier(0);
#pragma unroll
        for (int ai = 0; ai < 2; ++ai)
#pragma unroll
            for (int m = 0; m < 4; ++m) { const int row = row0 + ai * HALF + m * 16; float part = 0.f;
#pragma unroll
                for (int bj = 0; bj < 2; ++bj) { const size_t off = (size_t)row * 1024 + col0 + bj * 32; const u32x4 q = r[ai][m][bj];
                    const f32x4 b0 = (f32x4){__uint_as_float(q.x << 16), __uint_as_float(q.x & 0xffff0000u), __uint_as_float(q.y << 16), __uint_as_float(q.y & 0xffff0000u)};
                    const f32x4 b1 = (f32x4){__uint_as_float(q.z << 16), __uint_as_float(q.z & 0xffff0000u), __uint_as_float(q.w << 16), __uint_as_float(q.w & 0xffff0000u)};
                    const f32x4 o0 = b0 + acc[ai][bj][m][0] * alpha, o1 = b1 + acc[ai][bj][m][1] * alpha;
                    if (out32) { *(f32x4*)(out32 + off) = o0; *(f32x4*)(out32 + off + 4) = o1; }
                    else { u32x4 w; w.x = cvt_pk_bf16(o0[0], o0[1]); w.y = cvt_pk_bf16(o0[2], o0[3]); w.z = cvt_pk_bf16(o1[0], o1[1]); w.w = cvt_pk_bf16(o1[2], o1[3]);
                        *(u32x4*)(xb + off) = w;
                        part += (o0[0] * o0[0] + o0[1] * o0[1]) + (o0[2] * o0[2] + o0[3] * o0[3]) + (o1[0] * o1[0] + o1[1] * o1[1]) + (o1[2] * o1[2] + o1[3] * o1[3]); } }
                if (!out32) { part += __shfl_xor(part, 16); part += __shfl_xor(part, 32); if (fq == 0) unsafeAtomicAdd(ssn + row, part); } }
    }
};
struct EpiNull {
    static constexpr bool PERM = true, AFTER_DRAIN = false;
    float* sink;
    __device__ __forceinline__ void operator()(const f32x4 (&acc)[2][2][4][2], const Unit& u, int wr, int wc, int fr, int fq) const {
        float s = 0.f;
#pragma unroll
        for (int ai = 0; ai < 2; ++ai)
#pragma unroll
            for (int bj = 0; bj < 2; ++bj)
#pragma unroll
                for (int m = 0; m < 4; ++m)
#pragma unroll
                    for (int n = 0; n < 2; ++n) s += (acc[ai][bj][m][n][0] + acc[ai][bj][m][n][1]) + (acc[ai][bj][m][n][2] + acc[ai][bj][m][n][3]);
        if (s == 1.2345e33f) sink[0] = s;
    }
};
struct EpiWin {
    static constexpr bool PERM = true, AFTER_DRAIN = false;
    bf16_t *CU, *P, *Q, *Kq; const float* ss; const float *qg, *kg;
    __device__ __forceinline__ void operator()(const f32x4 (&acc)[2][2][4][2], const Unit& u, int wr, int wc, int fr, int fq) const {
        const int row0 = u.pm * BM + wr * 64 + fr, pn = u.pn;
        float rsv[2][4];
#pragma unroll
        for (int ai = 0; ai < 2; ++ai)
#pragma unroll
            for (int m = 0; m < 4; ++m) rsv[ai][m] = ss[row0 + ai * HALF + m * 16];
        __builtin_amdgcn_sched_barrier(0);
#pragma unroll
        for (int ai = 0; ai < 2; ++ai)
#pragma unroll
            for (int m = 0; m < 4; ++m) rsv[ai][m] = rsqrtf(rsv[ai][m] * (1.0f / 1024.0f) + NORM_EPS);
        if (pn < 2) {
#pragma unroll
            for (int ai = 0; ai < 2; ++ai)
#pragma unroll
                for (int m = 0; m < 4; ++m) { const int row = row0 + ai * HALF + m * 16; const float rs = rsv[ai][m]; float h[8];
#pragma unroll
                    for (int n = 0; n < 2; ++n)
#pragma unroll
                        for (int e = 0; e < 4; ++e) { const float a = acc[ai][0][m][n][e] * rs, g = acc[ai][1][m][n][e] * rs; h[4 * n + e] = a * fsigmoid(g); }
                    u32x4 w; w.x = cvt_pk_bf16(h[0], h[1]); w.y = cvt_pk_bf16(h[2], h[3]); w.z = cvt_pk_bf16(h[4], h[5]); w.w = cvt_pk_bf16(h[6], h[7]);
                    *(u32x4*)(CU + (size_t)row * 256 + pn * HALF + wc * 32 + 8 * fq) = w; }
        } else if (pn == 2) {
#pragma unroll
            for (int ai = 0; ai < 2; ++ai)
#pragma unroll
                for (int m = 0; m < 4; ++m) { const int row = row0 + ai * HALF + m * 16; const float rs = rsv[ai][m];
#pragma unroll
                    for (int bj = 0; bj < 2; ++bj) { const f32x4 v0 = acc[ai][bj][m][0] * rs, v1 = acc[ai][bj][m][1] * rs;
                        u32x4 w; w.x = cvt_pk_bf16(v0[0], v0[1]); w.y = cvt_pk_bf16(v0[2], v0[3]); w.z = cvt_pk_bf16(v1[0], v1[1]); w.w = cvt_pk_bf16(v1[2], v1[3]);
                        *(u32x4*)(P + (size_t)row * 256 + bj * HALF + wc * 32 + 8 * fq) = w; } }
        } else {
            const int which = (pn - 3) >> 1, head = 4 * ((pn - 3) & 1) + wc;
            const float* gp = (which ? kg : qg) + 8 * fq; const float post = which ? 1.0f : 0.125f;
            f32x4 gv[2][2];
#pragma unroll
            for (int bj = 0; bj < 2; ++bj)
#pragma unroll
                for (int n = 0; n < 2; ++n) gv[bj][n] = *(const f32x4*)(gp + 32 * bj + 4 * n) * post;
            bf16_t* dst = Q + head * 64 + 8 * fq;
#pragma unroll
            for (int ai = 0; ai < 2; ++ai)
#pragma unroll
                for (int m = 0; m < 4; ++m) { const int row = row0 + ai * HALF + m * 16; const float rs = rsv[ai][m];
                    f32x4 v[2][2]; float q = 0.f;
#pragma unroll
                    for (int bj = 0; bj < 2; ++bj)
#pragma unroll
                        for (int n = 0; n < 2; ++n) { v[bj][n] = acc[ai][bj][m][n] * rs; const f32x4 x = v[bj][n]; q += (x[0] * x[0] + x[1] * x[1]) + (x[2] * x[2] + x[3] * x[3]); }
                    q += __shfl_xor(q, 16); q += __shfl_xor(q, 32);
                    const float r2 = rsqrtf(q * (1.0f / 64.0f) + NORM_EPS);
#pragma unroll
                    for (int bj = 0; bj < 2; ++bj) { const f32x4 v0 = v[bj][0] * gv[bj][0] * r2, v1 = v[bj][1] * gv[bj][1] * r2;
                        u32x4 w; w.x = cvt_pk_bf16(v0[0], v0[1]); w.y = cvt_pk_bf16(v0[2], v0[3]); w.z = cvt_pk_bf16(v1[0], v1[1]); w.w = cvt_pk_bf16(v1[2], v1[3]);
                        if (which) { const int tb_ = row >> 12, ts_ = row & 4095, gr = ts_ >> 6, col = ts_ & 63;
                            *(u32x4*)(Kq + ((size_t)((tb_ * 8 + head) * 64 + gr) * 4096 + ((((col >> 2) & 1) * 2 + bj) * 8 + (col >> 3)) * 128 + (col & 3) * 32 + fq * 8)) = w; }
                        else *(u32x4*)(dst + (size_t)row * 512 + 32 * bj) = w; } }
        }
    }
};
struct EpiVT {
    static constexpr bool PERM = true, AFTER_DRAIN = false;
    bf16_t* VT; const float* ss; int ldv;
    __device__ __forceinline__ void operator()(const f32x4 (&acc)[2][2][4][2], const Unit& u, int wr, int wc, int fr, int fq) const {
        const int row0 = u.pm * BM + wr * 64 + fr, col0 = u.pn * BM + wc * 32 + 8 * fq;
        f32x4 rsv[2][2];
#pragma unroll
        for (int bj = 0; bj < 2; ++bj)
#pragma unroll
            for (int n = 0; n < 2; ++n) { const f32x4 s4 = *(const f32x4*)(ss + col0 + bj * HALF + 4 * n);
                rsv[bj][n] = (f32x4){rsqrtf(s4[0] * (1.0f / 1024.0f) + NORM_EPS), rsqrtf(s4[1] * (1.0f / 1024.0f) + NORM_EPS), rsqrtf(s4[2] * (1.0f / 1024.0f) + NORM_EPS), rsqrtf(s4[3] * (1.0f / 1024.0f) + NORM_EPS)}; }
#pragma unroll
        for (int ai = 0; ai < 2; ++ai)
#pragma unroll
            for (int m = 0; m < 4; ++m) { const int dim = row0 + ai * HALF + m * 16, hh = dim >> 6, d = dim & 63, jd = (d >> 2) & 3, frv = 4 * (d >> 4) + (d & 3);
#pragma unroll
                for (int bj = 0; bj < 2; ++bj) { const f32x4 v0 = acc[ai][bj][m][0] * rsv[bj][0], v1 = acc[ai][bj][m][1] * rsv[bj][1];
                    u32x4 w; w.x = cvt_pk_bf16(v0[0], v0[1]); w.y = cvt_pk_bf16(v0[2], v0[3]); w.z = cvt_pk_bf16(v1[0], v1[1]); w.w = cvt_pk_bf16(v1[2], v1[3]);
                    const int tok = col0 + bj * HALF, tb_ = tok >> 12, ts_ = tok & 4095, gr = ts_ >> 6, col = ts_ & 63;
                    *(u32x4*)(VT + ((size_t)((tb_ * 8 + hh) * 64 + gr) * 4096 + (jd * 8 + (col >> 3)) * 128 + frv * 8)) = w; } }
    }
};
template <class Epi, class Sched, bool ALIGN_EPI = false, bool SP2 = false>
__device__ __forceinline__ void gemm_phase(PG8_LAS unsigned char* lds, const Gemm g, const Sched& S, const Epi& E) {
    int tid_ = threadIdx.x; asm volatile("" : "+v"(tid_));
    const int tid = tid_, wid = __builtin_amdgcn_readfirstlane(tid >> 6), lane = tid & 63, wr = wid >> 2, wc = wid & 3, fr = lane & 15, fq = lane >> 4;
    const int K = g.K, nt = K / BK;
    unsigned voffA[2], voffB[2];
#pragma unroll
    for (int i = 0; i < 2; ++i) { int R, C; stage_rc(tid * 16 + i * 8192, R, C); const int Rb = Epi::PERM ? ((R & ~31) + perm32(R & 31)) : R;
        voffA[i] = (unsigned)(R * g.ldA + C) * 2u; voffB[i] = (unsigned)(Rb * g.ldB + C) * 2u; }
    const size_t kstep = (size_t)(BK * 2);
    const size_t hstep = (size_t)HALF * K * 2;
    const size_t tstep = 2 * hstep;
    const size_t kstepB = g.kstepB, hstepB = g.hstepB, tstepB = g.tstepB;
    const size_t kstepA = g.kstepA, hstepA = g.hstepA, tstepA = g.tstepA;
    const unsigned ldsw = (unsigned)wid * 1024u;
    const int aoff = lds_byte(wr * 64 + fr, fq * 8), boff = lds_byte(wc * 32 + fr, fq * 8);
#define PG8_SA(b, h) (((b) * 2 + (h)) * HTB)
#define PG8_SB(b, h) ((4 + (b) * 2 + (h)) * HTB)
#define PG8_STAGE(bufoff, gbase, voff) do { _Pragma("unroll") for (int _i = 0; _i < 2; ++_i) \
        __builtin_amdgcn_global_load_lds((const unsigned*)((const char*)(gbase) + (voff)[_i]), (PG8_LAS unsigned*)(lds + (bufoff) + ldsw + _i * 8192), 16, 0, 0); } while (0)
#define PG8_LDA(dst, b, h) do { _Pragma("unroll") for (int m = 0; m < 4; ++m) _Pragma("unroll") for (int k = 0; k < 2; ++k) dst[m][k] = *(const PG8_LAS bf16x8*)(lds + PG8_SA(b, h) + aoff + m * 2048 + k * 1024); } while (0)
#define PG8_LDB(dst, b, h) do { _Pragma("unroll") for (int n = 0; n < 2; ++n) _Pragma("unroll") for (int k = 0; k < 2; ++k) dst[n][k] = *(const PG8_LAS bf16x8*)(lds + PG8_SB(b, h) + boff + n * 2048 + k * 1024); } while (0)
#define PG8_MMA(ai, bj, At, Bt) do { __builtin_amdgcn_s_setprio(1); _Pragma("unroll") for (int m = 0; m < 4; ++m) _Pragma("unroll") for (int n = 0; n < 2; ++n) _Pragma("unroll") for (int k = 0; k < 2; ++k) \
        acc[ai][bj][m][n] = __builtin_amdgcn_mfma_f32_16x16x32_bf16(Bt[n][k], At[m][k], acc[ai][bj][m][n], 0, 0, 0); __builtin_amdgcn_s_setprio(0); } while (0)
#define PG8_WAIT_V(n) asm volatile("s_waitcnt vmcnt(" #n ")" ::: "memory")
#define PG8_WAIT_L(n) asm volatile("s_waitcnt lgkmcnt(" #n ")" ::: "memory")
#define PG8_BAR __builtin_amdgcn_s_barrier()
#define PG8_SCHED __builtin_amdgcn_sched_barrier(0)
    Unit cur, nxt; int ui = 0;
    if (!S.next(0, cur)) return;
    f32x4 acc[2][2][4][2];
#pragma unroll
    for (int a = 0; a < 2; ++a)
#pragma unroll
        for (int b = 0; b < 2; ++b)
#pragma unroll
            for (int m = 0; m < 4; ++m)
#pragma unroll
                for (int n = 0; n < 2; ++n) acc[a][b][m][n] = (f32x4){0.f, 0.f, 0.f, 0.f};
    bf16x8 At[4][2], B0[2][2], B1[2][2];
    const char* cA = (const char*)g.A + (size_t)cur.pm * tstepA; const char* cB = (const char*)g.Bt + (size_t)cur.pn * tstepB;
    S.a_ready(cur);
    if constexpr (SP2) {
        PG8_STAGE(PG8_SB(0, 0), cB, voffB); PG8_STAGE(PG8_SB(0, 1), cB + hstepB, voffB); PG8_STAGE(PG8_SA(0, 0), cA, voffA); PG8_STAGE(PG8_SA(0, 1), cA + hstepA, voffA);
        if (wr == 1) PG8_BAR;
        PG8_WAIT_V(2); PG8_BAR;
        PG8_STAGE(PG8_SB(1, 0), cB + kstepB, voffB); PG8_STAGE(PG8_SA(1, 0), cA + kstepA, voffA); PG8_STAGE(PG8_SB(1, 1), cB + hstepB + kstepB, voffB);
        PG8_WAIT_V(6); PG8_BAR;
    } else {
        PG8_STAGE(PG8_SB(0, 0), cB, voffB); PG8_STAGE(PG8_SA(0, 0), cA, voffA); PG8_STAGE(PG8_SB(0, 1), cB + hstepB, voffB); PG8_STAGE(PG8_SA(0, 1), cA + hstepA, voffA);
        if (wr == 1) PG8_BAR;
        PG8_WAIT_V(4); PG8_BAR;
        PG8_STAGE(PG8_SB(1, 0), cB + kstepB, voffB); PG8_STAGE(PG8_SA(1, 0), cA + kstepA, voffA); PG8_STAGE(PG8_SB(1, 1), cB + hstepB + kstepB, voffB);
        PG8_WAIT_V(6); PG8_BAR;
    }
    for (;;) {
        const bool has_next = S.next(ui + 1, nxt);
        const char* nA = has_next ? (const char*)g.A + (size_t)nxt.pm * tstepA : cA; const char* nB = has_next ? (const char*)g.Bt + (size_t)nxt.pn * tstepB : cB;
        for (int t = 0; t < nt; t += 2) {
            const bool last = (t == nt - 2);
            const char* a1 = cA + (size_t)(t + 1) * kstepA;
            const char* a2 = last ? nA : cA + (size_t)(t + 2) * kstepA; const char* b2 = last ? nB : cB + (size_t)(t + 2) * kstepB;
            const char* a3 = a2 + kstepA; const char* b3 = b2 + kstepB;
            if (last && has_next) S.a_ready(nxt);
            if constexpr (SP2) {
            PG8_LDB(B0, 0, 0); PG8_LDB(B1, 0, 1); PG8_SCHED; PG8_LDA(At, 0, 0); PG8_STAGE(PG8_SA(1, 1), a1 + hstepA, voffA);
            PG8_WAIT_V(8); PG8_WAIT_L(0); PG8_BAR; PG8_MMA(0, 0, At, B0); PG8_MMA(0, 1, At, B1); PG8_BAR; PG8_SCHED;
            PG8_LDA(At, 0, 1); PG8_STAGE(PG8_SB(0, 0), b2, voffB); PG8_STAGE(PG8_SB(0, 1), b2 + hstepB, voffB); PG8_STAGE(PG8_SA(0, 0), a2, voffA);
            PG8_WAIT_V(8); PG8_WAIT_L(0); PG8_BAR; PG8_MMA(1, 0, At, B0); PG8_MMA(1, 1, At, B1); PG8_BAR; PG8_SCHED;
            PG8_LDB(B0, 1, 0); PG8_LDB(B1, 1, 1); PG8_SCHED; PG8_LDA(At, 1, 0); PG8_STAGE(PG8_SA(0, 1), a2 + hstepA, voffA);
            PG8_WAIT_V(8); PG8_WAIT_L(0); PG8_BAR; PG8_MMA(0, 0, At, B0); PG8_MMA(0, 1, At, B1); PG8_BAR; PG8_SCHED;
            PG8_LDA(At, 1, 1); PG8_STAGE(PG8_SB(1, 0), b3, voffB); PG8_STAGE(PG8_SB(1, 1), b3 + hstepB, voffB); PG8_STAGE(PG8_SA(1, 0), a3, voffA);
            PG8_WAIT_V(8); PG8_WAIT_L(0); PG8_BAR; PG8_MMA(1, 0, At, B0); PG8_MMA(1, 1, At, B1); PG8_BAR; PG8_SCHED;
            } else {
            PG8_LDB(B0, 0, 0); PG8_SCHED; PG8_LDA(At, 0, 0); PG8_STAGE(PG8_SA(1, 1), a1 + hstepA, voffA);
            PG8_WAIT_L(8); PG8_BAR; PG8_WAIT_L(0); PG8_MMA(0, 0, At, B0); PG8_BAR; PG8_SCHED;
            PG8_LDB(B1, 0, 1); PG8_STAGE(PG8_SB(0, 0), b2, voffB);
            PG8_BAR; PG8_WAIT_L(0); PG8_MMA(0, 1, At, B1); PG8_BAR;
            PG8_LDA(At, 0, 1); PG8_STAGE(PG8_SA(0, 0), a2, voffA);
            PG8_BAR; PG8_WAIT_L(0); PG8_MMA(1, 0, At, B0); PG8_BAR; PG8_SCHED;
            PG8_STAGE(PG8_SB(0, 1), b2 + hstepB, voffB);
            PG8_WAIT_V(6); PG8_BAR; PG8_MMA(1, 1, At, B1); PG8_BAR;
            PG8_LDB(B0, 1, 0); PG8_SCHED; PG8_LDA(At, 1, 0); PG8_STAGE(PG8_SA(0, 1), a2 + hstepA, voffA);
            PG8_WAIT_L(8); PG8_BAR; PG8_WAIT_L(0); PG8_MMA(0, 0, At, B0); PG8_BAR; PG8_SCHED;
            PG8_LDB(B1, 1, 1); PG8_STAGE(PG8_SB(1, 0), b3, voffB);
            PG8_BAR; PG8_WAIT_L(0); PG8_MMA(0, 1, At, B1); PG8_BAR;
            PG8_LDA(At, 1, 1); PG8_STAGE(PG8_SA(1, 0), a3, voffA);
            PG8_BAR; PG8_WAIT_L(0); PG8_MMA(1, 0, At, B0); PG8_BAR; PG8_SCHED;
            PG8_STAGE(PG8_SB(1, 1), b3 + hstepB, voffB);
            PG8_WAIT_V(6); PG8_BAR; PG8_MMA(1, 1, At, B1); PG8_BAR;
            }
        }
        if constexpr (ALIGN_EPI) { if (wr == 0) PG8_BAR; }
        if constexpr (!Epi::AFTER_DRAIN) { E(acc, cur, wr, wc, fr, fq); S.done(cur); }
        if (!has_next) break;
#pragma unroll
        for (int a = 0; a < 2; ++a)
#pragma unroll
            for (int b = 0; b < 2; ++b)
#pragma unroll
                for (int m = 0; m < 4; ++m)
#pragma unroll
                    for (int n = 0; n < 2; ++n) acc[a][b][m][n] = (f32x4){0.f, 0.f, 0.f, 0.f};
        cur = nxt; cA = nA; cB = nB; ++ui;
        if constexpr (ALIGN_EPI) { if (wr == 1) PG8_BAR; }
    }
    PG8_WAIT_V(0);
    if constexpr (!ALIGN_EPI) { if (wr == 0) PG8_BAR; }
    PG8_BAR;
    if constexpr (Epi::AFTER_DRAIN) { E.fused(acc, cur, wr, wc, fr, fq, lds, wid, lane); S.done(cur); }
#undef PG8_SA
#undef PG8_SB
#undef PG8_STAGE
#undef PG8_LDA
#undef PG8_LDB
#undef PG8_MMA
#undef PG8_WAIT_V
#undef PG8_WAIT_L
#undef PG8_BAR
#undef PG8_SCHED
}
}

constexpr int DM = 1024, NB = 8, SEQ = 4096, MTOK = NB * SEQ, DFF = 2816, INW = 2304, NLAYER = 2, NHEAD = 8;
constexpr int NGU = 2 * DFF;
constexpr int NWIN = 1792;
constexpr float EPS = 1e-6f;
constexpr size_t MiB = 1u << 20;
constexpr size_t WS_CTL = 0, CTL_ZERO_BYTES = 262144; constexpr int CW_BAR = 4096;
constexpr size_t WS_SS = 1 * MiB;
constexpr size_t WS_W = 2 * MiB, W_LAYER = 40 * MiB;
constexpr size_t WO_GU1 = 0, WO_D1 = 11 * MiB, WO_WIN = WO_D1 + 5632 * 1024, WO_WV = WO_WIN + 3584 * 1024, WO_WO = WO_WV + 1 * MiB, WO_GU2 = WO_WO + 2 * MiB, WO_D2 = WO_GU2 + 11 * MiB;
static_assert(WO_D2 + 5632 * 1024 <= W_LAYER, "weights per layer");
constexpr size_t WS_XB = 82 * MiB;
constexpr size_t WS_H = 146 * MiB;
constexpr size_t WS_CU = WS_H, WS_P = WS_CU + 16 * MiB, WS_Q = WS_P + 16 * MiB, WS_K = WS_Q + 32 * MiB, WS_VT = WS_K + 32 * MiB;
constexpr size_t WS_Z = 322 * MiB, WS_END = 386 * MiB;
static_assert(WS_VT + 32 * MiB <= WS_Z && WS_W + 2 * W_LAYER <= WS_XB, "d_ws map");
constexpr int LDS_BYTES = 131072 + 30720 + 64;
constexpr int RPB_OFF = 131072, MISC_OFF = 131072 + 30720;

#define LAS __attribute__((address_space(3)))
typedef unsigned short bf16;
typedef unsigned v4u __attribute__((ext_vector_type(4)));
typedef unsigned v2u __attribute__((ext_vector_type(2)));
typedef float f32x4 __attribute__((ext_vector_type(4)));
typedef short bf16x8 __attribute__((ext_vector_type(8)));
#define LDS_WAIT() asm volatile("s_waitcnt lgkmcnt(0)" ::: "memory")
__device__ __forceinline__ float bf2f(unsigned short v) { return __uint_as_float((unsigned)v << 16); }
__device__ __forceinline__ unsigned pk2(float lo, float hi) { return pg8::cvt_pk_bf16(lo, hi); }
__device__ __forceinline__ float wave_sum(float v) {
#pragma unroll
    for (int o = 1; o < 64; o <<= 1) v += __shfl_xor(v, o);
    return v;
}

typedef __attribute__((address_space(1))) unsigned gu32;
#define RLX_AGENT __ATOMIC_RELAXED, __HIP_MEMORY_SCOPE_AGENT
#define XB_TMO      128
#define XB_XCNT(j)  (256  + 64 * (j))
#define XB_XSUB(j)  (1280 + 64 * (j))
#define XB_XGEN(j)  (2304 + 64 * (j))
#define XB_TOP      3328
#define XB_TOPGEN   3392
#define XCD_BAR_WORDS 3456
#define XB_SPIN_CAP (1u << 18)

__device__ __forceinline__ unsigned xb_ld(unsigned* p)              { return __hip_atomic_load(p, __ATOMIC_RELAXED, __HIP_MEMORY_SCOPE_AGENT); }
__device__ __forceinline__ unsigned xb_add(unsigned* p, unsigned v) { return __hip_atomic_fetch_add(p, v, __ATOMIC_RELAXED, __HIP_MEMORY_SCOPE_AGENT); }
__device__ __forceinline__ unsigned xb_xcc_id() { return (unsigned)__builtin_amdgcn_s_getreg((3 << 11) | 20) & 0xFu; }
#define XB_SPIN(cond, bar) do { unsigned _sp = 0; while (cond) { __builtin_amdgcn_s_sleep(1); \
    if ((++_sp & 255u) == 0u) { if (xb_ld(&(bar)[XB_TMO])) break; if (_sp > XB_SPIN_CAP) { atomicAdd(&(bar)[XB_TMO], 1u); break; } } } } while (0)

struct XcdBarrier {
    unsigned* bar; unsigned x; unsigned gsize;
    volatile LAS unsigned* st;
};

__device__ __forceinline__ XcdBarrier xcd_barrier_post(unsigned* bar, volatile LAS unsigned* st, unsigned gsize) {
    XcdBarrier b; b.bar = bar; b.x = xb_xcc_id(); b.st = st; b.gsize = gsize;
    if (threadIdx.x == 0) (void)xb_add(&bar[XB_XCNT(b.x)], 1u);
    return b;
}
__device__ __forceinline__ void xcd_barrier_complete(unsigned* bar, unsigned x, unsigned& nloc, unsigned& nx, unsigned G) {
    unsigned sum, cnt, mine, sp = 0u;
    for (;;) {
        sum = 0u; cnt = 0u; mine = 0u;
#pragma unroll
        for (unsigned j = 0; j < 16; ++j) { const unsigned c = xb_ld(&bar[XB_XCNT(j)]); sum += c; cnt += (c > 0u) ? 1u : 0u; mine = (j == x) ? c : mine; }
        if (sum == G) break;
        __builtin_amdgcn_s_sleep(1);
        if ((++sp & 255u) == 0u) { if (xb_ld(&bar[XB_TMO])) break; if (sp > XB_SPIN_CAP) { atomicAdd(&bar[XB_TMO], 1u); break; } }
    }
    nloc = mine > 0u ? mine : 1u; nx = cnt > 0u ? cnt : 1u;
}

__device__ __forceinline__ void xcd_barrier(const XcdBarrier& b) {
    asm volatile("s_waitcnt vmcnt(0)" ::: "memory");
    __syncthreads();
    if (threadIdx.x == 0) {
        unsigned* bar = b.bar;
        __builtin_amdgcn_s_waitcnt(0);
        unsigned nloc = b.st[0], nx = b.st[1];
        if (nloc == 0u) { xcd_barrier_complete(bar, b.x, nloc, nx, b.gsize); b.st[0] = nloc; b.st[1] = nx; }
        const unsigned old = xb_add(&bar[XB_XSUB(b.x)], 1u);
        const unsigned gen = old / nloc;
        if (old + 1u == (gen + 1u) * nloc) {
            __builtin_amdgcn_fence(__ATOMIC_RELEASE, "agent");
            asm volatile("s_waitcnt vmcnt(0)" ::: "memory");
            const unsigned og = xb_add(&bar[XB_TOP], 1u);
            const unsigned tg = og / nx;
            if (og + 1u == (tg + 1u) * nx) xb_add(&bar[XB_TOPGEN], 1u);
            else XB_SPIN(xb_ld(&bar[XB_TOPGEN]) == tg, bar);
            __builtin_amdgcn_fence(__ATOMIC_ACQUIRE, "agent");
            xb_add(&bar[XB_XGEN(b.x)], 1u);
            asm volatile("s_waitcnt vmcnt(0)" ::: "memory");
        } else {
            XB_SPIN(xb_ld(&bar[XB_XGEN(b.x)]) == gen, bar);
            __builtin_amdgcn_fence(__ATOMIC_ACQUIRE, "agent");
            asm volatile("s_waitcnt vmcnt(0)" ::: "memory");
        }
    }
    __syncthreads();
}

__device__ __forceinline__ int rescol32(int cc) { return (cc & ~255) | (((cc >> 5) & 3) << 6) | (((cc >> 7) & 1) << 5); }
__device__ __forceinline__ void tr_item(const float* W, int ldw, int srccol0, const float* g, bf16* Bt, int ldb, int dstrow0, int k0, int koff, LAS float* scr, int lane) {
    float tv[32]; const float* Wp = W + (size_t)(k0 + (lane >> 5)) * ldw + srccol0 + (lane & 31);
#pragma unroll
    for (int i = 0; i < 32; ++i) tv[i] = Wp[(size_t)(2 * i) * ldw];
    __builtin_amdgcn_sched_barrier(0);
#pragma unroll
    for (int i = 0; i < 32; ++i) { const int kk = 2 * i + (lane >> 5); float v = tv[i]; if (g) v *= g[k0 + kk]; scr[kk * 33 + (lane & 31)] = v; }
    LDS_WAIT(); asm volatile("" ::: "memory");
    const int c = lane & 7;
#pragma unroll
    for (int j = 0; j < 4; ++j) { const int n = (lane >> 3) + 8 * j; const LAS float* s = scr + (8 * c) * 33 + n;
        v4u o; o.x = pk2(s[0 * 33], s[1 * 33]); o.y = pk2(s[2 * 33], s[3 * 33]); o.z = pk2(s[4 * 33], s[5 * 33]); o.w = pk2(s[6 * 33], s[7 * 33]);
        const int rr = dstrow0 + n;
        *(v4u*)(Bt + ((size_t)((rr >> 8) * (ldb >> 6) + ((koff + k0) >> 6)) * 256 + (rr & 255)) * 64 + 8 * c) = o; }
    LDS_WAIT(); asm volatile("" ::: "memory");
}
__device__ __forceinline__ void fold_item(const float* L, int ldl, int kl0, const float* sc, const float* R, int J, bf16* Bt, int kd0, int n0, int lane) {
    float acc[8];
#pragma unroll
    for (int i = 0; i < 8; ++i) acc[i] = 0.f;
    const float* Lp = L + (size_t)kl0 * ldl; const float* Rp = R + n0 + lane;
#pragma unroll 1
    for (int j = 0; j < J; j += 32) { float wv[32];
#pragma unroll
        for (int u = 0; u < 32; ++u) wv[u] = Rp[(size_t)(j + u) * 1024];
        __builtin_amdgcn_sched_barrier(0);
        if (sc) {
#pragma unroll
            for (int u = 0; u < 32; ++u) wv[u] *= sc[j + u]; }
#pragma unroll
        for (int i = 0; i < 8; ++i) {
#pragma unroll
            for (int u = 0; u < 32; ++u) acc[i] += Lp[i * ldl + j + u] * wv[u];
            __builtin_amdgcn_sched_barrier(0); } }
    v4u o; o.x = pk2(acc[0], acc[1]); o.y = pk2(acc[2], acc[3]); o.z = pk2(acc[4], acc[5]); o.w = pk2(acc[6], acc[7]);
    { const int n = n0 + lane, rr = (n & ~255) | (((n >> 5) & 1) << 7) | (((n >> 6) & 3) << 5) | (n & 31);
      *(v4u*)(Bt + ((size_t)((rr >> 8) * 16 + (kd0 >> 6)) * 256 + (rr & 255)) * 64 + (kd0 & 63)) = o; }
}

struct Args { const float* in[22]; float* out; unsigned char* ws; };
constexpr int I_GU = 16 * 176, I_D = 44 * 32, I_WIN = 16 * 56, I_WV = 16 * 16, I_WO = 8 * 32, I_FOLD = 1024;
constexpr int I_LAYER = 2 * I_GU + 2 * I_D + I_WIN + I_WV + I_WO + I_FOLD;

__device__ __forceinline__ void prologue(const Args& a, LAS unsigned char* lds, int gw, int NGW, int wave, int lane) {
    LAS float* scr = (LAS float*)(lds + wave * 16384);
    unsigned char* ws = a.ws;
    for (int it = gw; it < NLAYER * I_LAYER; it += NGW) {
        const int l = it / I_LAYER; int r = it % I_LAYER;
        unsigned char* wl = ws + WS_W + (size_t)l * W_LAYER;
        if (r < 2 * I_GU) {
            const int f = r / I_GU; r %= I_GU; const int kb = r / 176, nb = r % 176, cc = 32 * nb, pn = cc >> 8, bj = (cc >> 7) & 1, j = cc & 127;
            const float* Wg = a.in[f ? 19 : 2] + (size_t)l * DM * DFF; const float* Wu = a.in[f ? 20 : 3] + (size_t)l * DM * DFF; const float* g = a.in[f ? 18 : 1] + l * DM;
            tr_item(bj ? Wu : Wg, DFF, 128 * pn + j, g, (bf16*)(wl + (f ? WO_GU2 : WO_GU1)), DM, cc, 64 * kb, 0, scr, lane); continue; }
        r -= 2 * I_GU;
        if (r < 2 * I_D) { const int f = r / I_D; r %= I_D; const int kb = r / 32, nb = r % 32;
            tr_item(a.in[f ? 21 : 4] + (size_t)l * DFF * DM, DM, rescol32(32 * nb), nullptr, (bf16*)(wl + (f ? WO_D2 : WO_D1)), DFF, 32 * nb, 64 * kb, 0, scr, lane); continue; }
        r -= 2 * I_D;
        if (r < I_WIN) { const int kb = r / 56, nb = r % 56, cc = 32 * nb; int src;
            if (cc < 512) { const int pn = cc >> 8, bj = (cc >> 7) & 1, j = cc & 127; src = (bj ? 256 : 0) + 128 * pn + j; }
            else if (cc < 768) src = cc;
            else { const int t = cc - 768, which = t >> 9, t2 = t & 511, pn2 = t2 >> 8, bj = (t2 >> 7) & 1, wc = (t2 >> 5) & 3; src = 768 + which * 512 + 256 * pn2 + 64 * wc + 32 * bj; }
            tr_item(a.in[6] + (size_t)l * DM * INW, INW, src, a.in[5] + l * DM, (bf16*)(wl + WO_WIN), DM, cc, 64 * kb, 0, scr, lane); continue; }
        r -= I_WIN;
        if (r < I_WV) { const int kb = r / 16, nb = r % 16;
            tr_item(a.in[6] + (size_t)l * DM * INW, INW, 1792 + 32 * nb, a.in[5] + l * DM, (bf16*)(wl + WO_WV), DM, 32 * nb, 64 * kb, 0, scr, lane); continue; }
        r -= I_WV;
        const float* wout = a.in[17] + (size_t)l * DM * DM;
        if (r < I_WO) { const int kb = r / 32, nb = r % 32;
            tr_item(wout + (size_t)512 * DM, DM, rescol32(32 * nb), nullptr, (bf16*)(wl + WO_WO), DM, 32 * nb, 64 * kb, 512, scr, lane); continue; }
        r -= I_WO;
        { const int kg = r / 16, nb = r % 16, k0 = 8 * kg;
            if (k0 < 256) fold_item(a.in[11] + (size_t)l * 65536, 256, k0, nullptr, wout, 256, (bf16*)(wl + WO_WO), k0, 64 * nb, lane);
            else { const int gi = (k0 - 256) >> 6, c0 = (k0 - 256) & 63;
                fold_item(a.in[12] + (size_t)l * 16384 + gi * 4096, 64, c0, a.in[13] + l * 256 + 64 * gi, wout + (size_t)(256 + 64 * gi) * DM, 64, (bf16*)(wl + WO_WO), k0, 64 * nb, lane); } }
    }
    const float* x = a.in[0]; bf16* XB = (bf16*)(ws + WS_XB); float* SS = (float*)(ws + WS_SS);
    for (int m0 = gw * 4; m0 < MTOK; m0 += NGW * 4) {
        f32x4 v[4][4];
#pragma unroll
        for (int q = 0; q < 4; ++q) { const f32x4* xr = (const f32x4*)(x + (size_t)(m0 + q) * DM) + lane;
#pragma unroll
            for (int j = 0; j < 4; ++j) v[q][j] = xr[64 * j]; }
        __builtin_amdgcn_sched_barrier(0);
#pragma unroll
        for (int q = 0; q < 4; ++q) { float s = 0.f;
#pragma unroll
            for (int j = 0; j < 4; ++j) s += (v[q][j].x * v[q][j].x + v[q][j].y * v[q][j].y) + (v[q][j].z * v[q][j].z + v[q][j].w * v[q][j].w);
            s = wave_sum(s);
            v2u* o8 = (v2u*)(XB + (size_t)(m0 + q) * DM) + lane;
#pragma unroll
            for (int j = 0; j < 4; ++j) { v2u w; w.x = pk2(v[q][j].x, v[q][j].y); w.y = pk2(v[q][j].z, v[q][j].w); o8[64 * j] = w; }
            if (lane == 0) SS[m0 + q] = s; }
    }
    for (int i = gw * 64 + lane; i < 5 * MTOK; i += NGW * 64) SS[MTOK + i] = 0.f;
}

#define SCHED_FENCE() __builtin_amdgcn_sched_barrier(0)
__device__ __forceinline__ void attn_unit(int b, int h, int r, int cb, const bf16* Q, const bf16* K, const bf16* VT, const LAS float* rpbs, bf16* Z, int lane) {
    const int fr = lane & 15, fq = lane >> 4;
    const int r0 = min(max(r - 4, 0), 56), kstart = min(max(16 * cb - 8, 0), 32), qcol = 16 * cb + fr, c0 = min(max(qcol - 8, 0), 48);
    const size_t tokb = (size_t)b * SEQ;
    const bf16* qp = Q + (tokb + r * 64 + qcol) * 512 + h * 64 + 8 * fq;
    const bf16x8 q0 = *(const bf16x8*)qp, q1 = *(const bf16x8*)(qp + 32);
    const int g0 = kstart >> 3;
    const char* kb = (const char*)(K + ((size_t)((b * 8 + h) * 64 + r0) * 4096 + g0 * 128));
    const unsigned koff = (unsigned)(fr * 64 + fq * 16);
    bf16x8 kf[8][2][2];
#pragma unroll
    for (int i = 0; i < 8; ++i)
#pragma unroll
        for (int t = 0; t < 2; ++t)
#pragma unroll
            for (int ks = 0; ks < 2; ++ks) kf[i][t][ks] = *(const bf16x8*)(kb + (size_t)(i * 8192 + (t * 2 + ks) * 2048) + koff);
    SCHED_FENCE();
    f32x4 s[8][2];
#pragma unroll
    for (int i = 0; i < 8; ++i)
#pragma unroll
        for (int t = 0; t < 2; ++t) { f32x4 c = (f32x4){0.f, 0.f, 0.f, 0.f};
            c = __builtin_amdgcn_mfma_f32_16x16x32_bf16(kf[i][t][0], q0, c, 0, 0, 0); c = __builtin_amdgcn_mfma_f32_16x16x32_bf16(kf[i][t][1], q1, c, 0, 0, 0); s[i][t] = c; }
    SCHED_FENCE();
    const char* vb = (const char*)(VT + ((size_t)((b * 8 + h) * 64 + r0) * 4096 + g0 * 128));
    const unsigned voff = (unsigned)(fq * 256 + fr * 16);
    bf16x8 vf[8][4];
#pragma unroll
    for (int i = 0; i < 8; ++i)
#pragma unroll
        for (int jd = 0; jd < 4; ++jd) vf[i][jd] = *(const bf16x8*)(vb + (size_t)(i * 8192 + jd * 2048) + voff);
    SCHED_FENCE();
    float negm[8];
#pragma unroll
    for (int j = 0; j < 8; ++j) { const int kc = kstart + 8 * fq + j; negm[j] = ((kc >= c0) && (kc < c0 + 16)) ? 0.f : -1.0e30f; }
    float mx = -3.0e38f;
    const LAS float* bp0 = rpbs + (h * 15 + (r0 - r + 7)) * 64 + (kstart + 8 * fq - qcol + 15 + 16);
#pragma unroll
    for (int i = 0; i < 8; ++i) { float bv[8];
#pragma unroll
        for (int j = 0; j < 8; ++j) bv[j] = bp0[i * 64 + j];
#pragma unroll
        for (int t = 0; t < 2; ++t)
#pragma unroll
            for (int e = 0; e < 4; ++e) { const int j = 4 * t + e; const float v = (s[i][t][e] + bv[j]) + negm[j]; s[i][t][e] = v; mx = fmaxf(mx, v); } }
    mx = fmaxf(mx, __shfl_xor(mx, 16)); mx = fmaxf(mx, __shfl_xor(mx, 32));
    float l = 0.f; bf16x8 pb[8];
#pragma unroll
    for (int i = 0; i < 8; ++i) { float p[8];
#pragma unroll
        for (int t = 0; t < 2; ++t)
#pragma unroll
            for (int e = 0; e < 4; ++e) { const float pv = __expf(s[i][t][e] - mx); p[4 * t + e] = pv; l += pv; }
        v4u w; w.x = pk2(p[0], p[1]); w.y = pk2(p[2], p[3]); w.z = pk2(p[4], p[5]); w.w = pk2(p[6], p[7]);
        pb[i] = __builtin_bit_cast(bf16x8, w); }
    l += __shfl_xor(l, 16); l += __shfl_xor(l, 32);
    SCHED_FENCE();
    f32x4 o[4];
#pragma unroll
    for (int jd = 0; jd < 4; ++jd) o[jd] = (f32x4){0.f, 0.f, 0.f, 0.f};
#pragma unroll
    for (int i = 0; i < 8; ++i)
#pragma unroll
        for (int jd = 0; jd < 4; ++jd) o[jd] = __builtin_amdgcn_mfma_f32_16x16x32_bf16(vf[i][jd], pb[i], o[jd], 0, 0, 0);
    const float il = 1.0f / l;
    bf16* zp = Z + (tokb + r * 64 + qcol) * 1024 + 512 + h * 64 + 16 * fq;
    v4u w0, w1;
    w0.x = pk2(o[0][0] * il, o[0][1] * il); w0.y = pk2(o[0][2] * il, o[0][3] * il); w0.z = pk2(o[1][0] * il, o[1][1] * il); w0.w = pk2(o[1][2] * il, o[1][3] * il);
    w1.x = pk2(o[2][0] * il, o[2][1] * il); w1.y = pk2(o[2][2] * il, o[2][3] * il); w1.z = pk2(o[3][0] * il, o[3][1] * il); w1.w = pk2(o[3][2] * il, o[3][3] * il);
    *(v4u*)zp = w0; *(v4u*)(zp + 8) = w1;
    SCHED_FENCE();
}
__device__ __forceinline__ void conv_load(const bf16* cp, int tb, unsigned short (&raw)[38]) {
#pragma unroll
    for (int j = 0; j < 38; ++j) raw[j] = cp[(ptrdiff_t)(tb - 15) * 256 + j * 256];
}
__device__ __forceinline__ void conv_item(int item, const bf16* CU, const float* dw, const float* dwb, const float* lng, const float* lnb, bf16* Z, LAS float* st, int tid) {
    const int b = item >> 6, t0 = (item & 63) * 64, c = tid & 255, half = tid >> 8, lane = tid & 63, wave = tid >> 6;
    const bf16* cp = CU + (size_t)b * SEQ * 256 + c;
    unsigned short raw[38], rawn[38];
    conv_load(cp, t0 + half * 32, raw);
    float w[31];
#pragma unroll
    for (int k = 0; k < 31; ++k) w[k] = dw[k * 256 + c];
    const float bias = dwb[c];
#pragma unroll
    for (int ch = 0; ch < 4; ++ch) { const int tb = t0 + half * 32 + ch * 8;
        if (ch < 3) conv_load(cp, tb + 8, rawn);
        SCHED_FENCE();
        float in[38];
#pragma unroll
        for (int j = 0; j < 38; ++j) { const int tt = tb - 15 + j; in[j] = (tt >= 0 && tt < SEQ) ? bf2f(raw[j]) : 0.f; }
#pragma unroll
        for (int o = 0; o < 8; ++o) { float acc = bias;
#pragma unroll
            for (int k = 0; k < 31; ++k) acc += w[k] * in[o + k];
            st[(half * 32 + ch * 8 + o) * 256 + c] = acc; }
        SCHED_FENCE();
        if (ch < 3) {
#pragma unroll
            for (int j = 0; j < 38; ++j) raw[j] = rawn[j]; } }
    __syncthreads();
    const f32x4 g4 = *(const f32x4*)(lng + 4 * lane), b4 = *(const f32x4*)(lnb + 4 * lane);
    f32x4 v[8];
#pragma unroll
    for (int tt = 0; tt < 8; ++tt) v[tt] = *(const LAS f32x4*)(st + (8 * wave + tt) * 256 + 4 * lane);
#pragma unroll
    for (int tt = 0; tt < 8; ++tt) { const int tok = 8 * wave + tt;
        const float mean = wave_sum((v[tt].x + v[tt].y) + (v[tt].z + v[tt].w)) * (1.0f / 256.0f); const f32x4 d = v[tt] - mean;
        const float var = wave_sum((d.x * d.x + d.y * d.y) + (d.z * d.z + d.w * d.w)) * (1.0f / 256.0f); const float rstd = rsqrtf(var + EPS);
        f32x4 y = d * rstd * g4 + b4;
        y.x *= pg8::fsigmoid(y.x); y.y *= pg8::fsigmoid(y.y); y.z *= pg8::fsigmoid(y.z); y.w *= pg8::fsigmoid(y.w);
        v2u o; o.x = pk2(y.x, y.y); o.y = pk2(y.z, y.w);
        *(v2u*)(Z + ((size_t)b * SEQ + t0 + tok) * 1024 + 4 * lane) = o; }
    __syncthreads();
}
template <int W> __device__ __forceinline__ void pool_compute(const float (&in)[48], int tb, bf16* zp) {
#pragma unroll
    for (int o = 0; o < 32; ++o) { float sum = 0.f;
#pragma unroll
        for (int k = 0; k < W; ++k) sum += in[o + 8 - W / 2 + k];
        const int t = tb + o, lo = max(t - W / 2, 0), hi = min(t - W / 2 + W, SEQ);
        const float mixed = sum / (float)(hi - lo) - in[o + 8];
        zp[(size_t)o * 1024] = (bf16)(pk2(mixed, 0.f) & 0xffffu); }
}
__device__ __forceinline__ void pool_item(int item, const bf16* P, bf16* Z, int tid) {
    const int b = item >> 6, t0 = (item & 63) * 64, c = tid & 255, half = tid >> 8, g = __builtin_amdgcn_readfirstlane(c >> 6), tb = t0 + half * 32;
    const bf16* pc = P + (size_t)b * SEQ * 256 + c;
    unsigned short raw[48];
#pragma unroll
    for (int j = 0; j < 48; ++j) raw[j] = pc[(ptrdiff_t)(tb - 8) * 256 + j * 256];
    SCHED_FENCE();
    float in[48];
#pragma unroll
    for (int j = 0; j < 48; ++j) { const int tt = tb - 8 + j; in[j] = (tt >= 0 && tt < SEQ) ? bf2f(raw[j]) : 0.f; }
    bf16* zp = Z + ((size_t)b * SEQ + tb) * 1024 + 256 + c;
    if (g == 0) pool_compute<2>(in, tb, zp); else if (g == 1) pool_compute<4>(in, tb, zp); else if (g == 2) pool_compute<8>(in, tb, zp); else pool_compute<16>(in, tb, zp);
    SCHED_FENCE();
}

constexpr int NGRP = 8, MG = SEQ;
#ifndef WGM_G1
#define WGM_G1 4
#endif
#ifndef WGM_G2
#define WGM_G2 8
#endif
#ifndef WGM_G3
#define WGM_G3 8
#endif
#ifndef WGM_G4
#define WGM_G4 8
#endif
#ifndef WGM_VT
#define WGM_VT 2
#endif
#ifndef STAGGER_TICKS
#define STAGGER_TICKS 0
#endif
__device__ __forceinline__ int grp_opaque() { int g_ = (int)(blockIdx.x & 7u); asm volatile("" : "+s"(g_)); return g_; }
__device__ __forceinline__ XcdBarrier grp_bar(unsigned char* ws, LAS unsigned char* lds) {
    XcdBarrier b; b.bar = (unsigned*)(ws + WS_CTL) + CW_BAR + grp_opaque() * XCD_BAR_WORDS; b.x = xb_xcc_id(); b.st = (volatile LAS unsigned*)(lds + MISC_OFF); b.gsize = gridDim.x >> 3; return b; }
#define GP_TOK0   ((size_t)grp_opaque() * MG)
#define GP_SS(k)  ((float*)(a.ws + WS_SS) + (size_t)(k) * MTOK + GP_TOK0)
#define GP_XB     ((bf16*)(a.ws + WS_XB) + GP_TOK0 * DM)
#define GP_Z      ((bf16*)(a.ws + WS_Z) + GP_TOK0 * DM)
#define GP_HG     (a.ws + WS_H + (size_t)grp_opaque() * (22 * MiB))
#define GP_H      ((bf16*)GP_HG)
#define GP_CU     ((bf16*)GP_HG)
#define GP_P      ((bf16*)(GP_HG + 2 * MiB))
#define GP_Q      ((bf16*)(GP_HG + 4 * MiB))
#define GP_K      ((bf16*)(GP_HG + 8 * MiB))
#define GP_VT     ((bf16*)(GP_HG + 12 * MiB))
#define GROUP_BARRIER() xcd_barrier(grp_bar(a.ws, lds))
__global__ void __launch_bounds__(512, 2) fwd_megakernel(Args a) {
    extern __shared__ __attribute__((aligned(16))) unsigned char lds_raw[];
    LAS unsigned char* lds = (LAS unsigned char*)lds_raw;
    cg::grid_group grid = cg::this_grid();
    {
        const int tid = threadIdx.x, lane = tid & 63, wave = __builtin_amdgcn_readfirstlane(tid >> 6);
        const int G = gridDim.x, bid = blockIdx.x, vcu = (bid % 8) * (G / 8) + bid / 8;
        { volatile LAS unsigned* misc = (volatile LAS unsigned*)(lds + MISC_OFF); if (tid < 16) misc[tid] = 0u; }
        __syncthreads();
        prologue(a, lds, vcu * 8 + wave, G * 8, wave, lane);
        grid.sync();
        (void)xcd_barrier_post((unsigned*)(a.ws + WS_CTL) + CW_BAR + grp_opaque() * XCD_BAR_WORDS, (volatile LAS unsigned*)(lds + MISC_OFF), (unsigned)(G >> 3));
#if STAGGER_TICKS > 0
        { const int grp = grp_opaque(); if (grp) { const unsigned long long t0 = __builtin_amdgcn_s_memrealtime(); while (__builtin_amdgcn_s_memrealtime() - t0 < (unsigned long long)(grp * STAGGER_TICKS)) __builtin_amdgcn_s_sleep(8); } }
#endif
    }
#pragma unroll 1
    for (int step = 0; step < 2 * NLAYER; ++step) {
        const int l = step >> 1, f = step & 1;
        const int gc = (int)(blockIdx.x >> 3), Gg = (int)(gridDim.x >> 3);
        if (f == 1) {
            { unsigned char* wl = a.ws + WS_W + (size_t)l * W_LAYER;
              pg8::Gemm g = pg8::Gemm::make(GP_XB, false, (const bf16*)(wl + WO_WIN), true, MG, NWIN, DM); typedef pg8::GroupOrder<MG / 256, NWIN / 256, WGM_G3, 0> Ord; Ord S; S.init(Gg, gc);
              pg8::EpiWin E{GP_CU, GP_P, GP_Q, GP_K, GP_SS(3 * l + 1), a.in[14] + l * 64, a.in[15] + l * 64};
              pg8::gemm_phase<pg8::EpiWin, Ord, true, true>(lds, g, S, E); }
            { unsigned char* wl = a.ws + WS_W + (size_t)l * W_LAYER;
              pg8::Gemm g = pg8::Gemm::make((const bf16*)(wl + WO_WV), true, GP_XB, false, 512, MG, DM); typedef pg8::GroupOrder<2, MG / 256, WGM_VT, 0> Ord; Ord S; S.init(Gg, gc);
              pg8::EpiVT E{GP_VT, GP_SS(3 * l + 1), MG};
              pg8::gemm_phase<pg8::EpiVT, Ord, true, true>(lds, g, S, E); }
            GROUP_BARRIER();
            {
                int mt_ = threadIdx.x; asm volatile("" : "+v"(mt_));
                const int tid = mt_, lane = tid & 63, wave = __builtin_amdgcn_readfirstlane(tid >> 6);
                LAS float* rpbs = (LAS float*)(lds + RPB_OFF);
                const float* rpb = a.in[16] + (size_t)l * 3720;
                for (int i = tid; i < 8 * 15 * 64; i += 512) { const int dc = (i & 63) - 16; rpbs[i] = (dc >= 0 && dc < 31) ? rpb[(i >> 6) * 31 + dc] : 0.f; }
                __syncthreads();
                { const bf16* Qb = GP_Q; const bf16* Kb = GP_K; const bf16* VT = GP_VT; bf16* Z = GP_Z;
                  for (int it = gc; it < 256; it += Gg) { const int hh = it >> 5, rp = it & 31;
                      attn_unit(0, hh, 2 * rp + (wave >> 2), wave & 3, Qb, Kb, VT, rpbs, Z, lane); } }
                __syncthreads();
                { const bf16* CU = GP_CU; const bf16* P = GP_P; bf16* Z = GP_Z;
                  for (int it = gc; it < 64; it += Gg)
                      conv_item(it, CU, a.in[7] + (size_t)l * 31 * 256, a.in[8] + l * 256, a.in[9] + l * 256, a.in[10] + l * 256, Z, (LAS float*)lds, tid);
                  for (int it = gc; it < 64; it += Gg) pool_item(it, P, Z, tid); }
                __syncthreads();
            }
            GROUP_BARRIER();
            { unsigned char* wl = a.ws + WS_W + (size_t)l * W_LAYER;
              pg8::Gemm g = pg8::Gemm::make(GP_Z, false, (const bf16*)(wl + WO_WO), true, MG, DM, DM); typedef pg8::GroupOrder<MG / 256, DM / 256, WGM_G4, 0> Ord; Ord S; S.init(Gg, gc);
              pg8::EpiResid E{nullptr, nullptr, GP_XB, GP_SS(3 * l + 2), 1.0f};
              pg8::gemm_phase<pg8::EpiResid, Ord, true, true>(lds, g, S, E); }
            GROUP_BARRIER();
        }
        { unsigned char* wl = a.ws + WS_W + (size_t)l * W_LAYER;
          pg8::Gemm g = pg8::Gemm::make(GP_XB, false, (const bf16*)(wl + (f ? WO_GU2 : WO_GU1)), true, MG, NGU, DM); typedef pg8::GroupOrder<MG / 256, NGU / 256, WGM_G1, 0> Ord; Ord S; S.init(Gg, gc);
          pg8::EpiSwiglu E{GP_H, DFF / 64, GP_SS(3 * l + (f ? 2 : 0))};
#ifdef PROBE_G1NULL
          { pg8::EpiNull EN{GP_SS(5)}; pg8::gemm_phase<pg8::EpiNull, Ord, true, true>(lds, g, S, EN); }
#endif
          pg8::gemm_phase<pg8::EpiSwiglu, Ord, true, true>(lds, g, S, E); }
        GROUP_BARRIER();
        { unsigned char* wl = a.ws + WS_W + (size_t)l * W_LAYER;
          pg8::Gemm g = pg8::Gemm::make(GP_H, true, (const bf16*)(wl + (f ? WO_D2 : WO_D1)), true, MG, DM, DFF);   typedef pg8::GroupOrder<MG / 256, DM / 256, WGM_G2, 1> Ord; Ord S; S.init(Gg, gc);
          const bool last = (step == 2 * NLAYER - 1);
          pg8::EpiResid E{step == 0 ? a.in[0] + GP_TOK0 * DM : nullptr, last ? a.out + GP_TOK0 * DM : nullptr, GP_XB, last ? nullptr : GP_SS(f ? 3 * (l + 1) : 3 * l + 1), 0.5f};
#ifdef PROBE_G2NULL
          { pg8::EpiNull EN{GP_SS(5)}; pg8::gemm_phase<pg8::EpiNull, Ord, true, true>(lds, g, S, EN); }
#endif
          pg8::gemm_phase<pg8::EpiResid, Ord, true, true>(lds, g, S, E); }
        if (step != 2 * NLAYER - 1) GROUP_BARRIER();
    }
}

extern "C" void kernel_launch(void* const* d_in, const int* in_sizes, int n_in, void* d_out, int out_size, void* d_ws, size_t ws_size, hipStream_t stream) {
    static int grid = 0;
    if (grid == 0) {
        if (n_in != 22 || in_sizes[0] != MTOK * DM || out_size != MTOK * DM || ws_size < WS_END) { fprintf(stderr, "kernel_launch: unexpected shapes (n_in %d, in0 %d, out %d, ws %zu); nothing launched\n", n_in, n_in > 0 ? in_sizes[0] : -1, out_size, ws_size); grid = -1; return; }
        int dev = 0, cus = 0, per_cu = 0;
        if (hipGetDevice(&dev) != hipSuccess || hipDeviceGetAttribute(&cus, hipDeviceAttributeMultiprocessorCount, dev) != hipSuccess) { grid = -1; return; }
        if (hipFuncSetAttribute((const void*)fwd_megakernel, hipFuncAttributeMaxDynamicSharedMemorySize, LDS_BYTES) != hipSuccess) { fprintf(stderr, "kernel_launch: hipFuncSetAttribute failed\n"); grid = -1; return; }
        if (hipOccupancyMaxActiveBlocksPerMultiprocessor(&per_cu, (const void*)fwd_megakernel, 512, LDS_BYTES) != hipSuccess || per_cu < 1) { fprintf(stderr, "kernel_launch: occupancy query gave %d\n", per_cu); (void)hipGetLastError(); per_cu = 1; }
        grid = cus * 1; if (grid % 8 != 0 || grid < 8) { fprintf(stderr, "kernel_launch: %d CUs: the group program needs a multiple of 8 workgroups\n", grid); grid = -1; return; }
    }
    if (grid < 0) return;
    if (hipMemsetAsync((char*)d_ws + WS_CTL, 0, CTL_ZERO_BYTES, stream) != hipSuccess) { fprintf(stderr, "kernel_launch: hipMemsetAsync failed\n"); return; }
    Args a{};
    for (int i = 0; i < 22; ++i) a.in[i] = (const float*)d_in[i];
    a.out = (float*)d_out; a.ws = (unsigned char*)d_ws;
    void* args[] = {&a};
    hipError_t e = hipLaunchCooperativeKernel((const void*)fwd_megakernel, dim3(grid), dim3(512), args, LDS_BYTES, stream);
    if (e != hipSuccess) fprintf(stderr, "kernel_launch: cooperative launch failed: %s (grid %d)\n", hipGetErrorString(e), grid);
}
```

```cpp
#include <hip/hip_runtime.h>
#include <hip/hip_cooperative_groups.h>
#include <cstdio>
#include <cstdint>
namespace cg = cooperative_groups;
namespace pg8 {
#define PG8_LAS __attribute__((address_space(3)))
typedef unsigned short bf16_t;
typedef short bf16x8 __attribute__((ext_vector_type(8)));
typedef float f32x4 __attribute__((ext_vector_type(4)));
typedef unsigned u32x4 __attribute__((ext_vector_type(4)));
constexpr int BM = 256, BK = 64, HALF = 128, HTB = HALF * BK * 2  , STAGE_BYTES = 8 * HTB, NXCD = 8, WGM = 8;

__host__ __device__ __forceinline__ int lds_byte(int r, int c) { const int st = (r >> 4) * 2 + (c >> 5), rr = r & 15, cc = c & 31, ob = rr * 64 + cc * 2; return st * 1024 + (ob ^ (((ob >> 9) & 1) << 5)); }
__host__ __device__ __forceinline__ void stage_rc(int b, int& R, int& C) { const int st = b / 1024, sb = b % 1024, swz = sb ^ (((sb >> 9) & 1) << 5); R = (st >> 1) * 16 + swz / 64; C = (st & 1) * 32 + (swz % 64) / 2; }
__host__ __device__ __forceinline__ int perm32(int rho) { const int n = rho >> 4, i = rho & 15; return 8 * (i >> 2) + 4 * n + (i & 3); }

struct Unit { int pm, pn; };
struct Gemm { const bf16_t* A; const bf16_t* Bt; int M, N, K; int ldA; size_t kstepA, hstepA, tstepA; int ldB; size_t kstepB, hstepB, tstepB;
    __host__ __device__ static Gemm make(const bf16_t* A, bool tmA, const bf16_t* Bt, bool tmB, int M, int N, int K) {
        const size_t ks = (size_t)(BK * 2), hs = (size_t)HALF * K * 2, ts = (size_t)BM * K * 2, kst = (size_t)(BM * BK * 2), hst = (size_t)(HALF * BK * 2), tst = (size_t)(K / BK) * (BM * BK * 2);
        return Gemm{A, Bt, M, N, K, tmA ? BK : K, tmA ? kst : ks, tmA ? hst : hs, tmA ? tst : ts, tmB ? BK : K, tmB ? kst : ks, tmB ? hst : hs, tmB ? tst : ts}; } };

struct StaticOrder {
    int nM, nN, nwg, G, c, rev;
    __host__ __device__ void init(int M, int N, int G_, int c_, int rev_ = 0) { nM = M / BM; nN = N / BM; nwg = nM * nN; G = G_; c = c_; rev = rev_; }
    __host__ __device__ bool next(int i, Unit& u) const {
        const long L = (long)i * G + c; if (L >= nwg) return false;
        int wgid = (int)L; { const int q = nwg / NXCD, r = nwg % NXCD, xcd = wgid % NXCD, off = wgid / NXCD; wgid = (xcd < r ? xcd * (q + 1) : r * (q + 1) + (xcd - r) * q) + off; }
        const int nig = WGM * nN, gid = wgid / nig, fm = gid * WGM, gsz = (nM - fm) < WGM ? (nM - fm) : WGM;
        u.pm = fm + ((wgid % nig) % gsz); u.pn = (wgid % nig) / gsz; if (rev) u.pm = nM - 1 - u.pm; return true;
    }
    __device__ __forceinline__ void a_ready(const Unit&) const {}
    __device__ __forceinline__ void done(const Unit&) const {}
};

template <int NM, int NN, int W, int REV> struct GroupOrder {
    int G, c;
    __host__ __device__ void init(int G_, int c_) { G = G_; c = c_; }
    __host__ __device__ bool next(int i, Unit& u) const {
        const int wgid = i * G + c; if (wgid >= NM * NN) return false;
        constexpr int nig = W * NN; const int gid = wgid / nig, fm = gid * W, gsz = (NM % W == 0) ? W : ((NM - fm) < W ? (NM - fm) : W), w = wgid % nig;
        u.pm = fm + (w % gsz); u.pn = w / gsz; if (REV) u.pm = NM - 1 - u.pm; return true;
    }
    __device__ __forceinline__ void a_ready(const Unit&) const {}
    __device__ __forceinline__ void done(const Unit&) const {}
};
__device__ __forceinline__ unsigned cvt_pk_bf16(float lo, float hi) { unsigned r; asm volatile("v_cvt_pk_bf16_f32 %0, %1, %2" : "=v"(r) : "v"(lo), "v"(hi)); return r; }
typedef float f32x2 __attribute__((ext_vector_type(2)));
constexpr float NORM_EPS = 1e-6f;
__device__ __forceinline__ float fsigmoid(float x) { return __builtin_amdgcn_rcpf(1.0f + __expf(-x)); }
__device__ __forceinline__ float row_rstd(const float* ss, int row) { return rsqrtf(ss[row] * (1.0f / 1024.0f) + NORM_EPS); }

struct EpiSwiglu {
    static constexpr bool PERM = true, AFTER_DRAIN = false;
    bf16_t* H; int nkt; const float* ss;
    __device__ __forceinline__ void operator()(const f32x4 (&acc)[2][2][4][2], const Unit& u, int wr, int wc, int fr, int fq) const {
        const int row0 = u.pm * BM + wr * 64 + fr, col0 = u.pn * HALF + wc * 32 + 8 * fq;
        float rsv[2][4];
#pragma unroll
        for (int ai = 0; ai < 2; ++ai)
#pragma unroll
            for (int m = 0; m < 4; ++m) rsv[ai][m] = ss[row0 + ai * HALF + m * 16];
        __builtin_amdgcn_sched_barrier(0);
#pragma unroll
        for (int ai = 0; ai < 2; ++ai)
#pragma unroll
            for (int m = 0; m < 4; ++m) { const int row = row0 + ai * HALF + m * 16; const float rs = rsqrtf(rsv[ai][m] * (1.0f / 1024.0f) + NORM_EPS), rs2 = rs * rs, cz = rs * -1.4426950408889634f;
                unsigned w[4];
#pragma unroll
                for (int n = 0; n < 2; ++n)
#pragma unroll
                    for (int p = 0; p < 2; ++p) { const f32x2 ag = (f32x2){acc[ai][0][m][n][2 * p], acc[ai][0][m][n][2 * p + 1]}, au = (f32x2){acc[ai][1][m][n][2 * p], acc[ai][1][m][n][2 * p + 1]};
                        const f32x2 t = ag * au, z = ag * cz;
                        f32x2 d; d.x = __builtin_amdgcn_exp2f(z.x); d.y = __builtin_amdgcn_exp2f(z.y); d = d + 1.0f;
                        f32x2 r; r.x = __builtin_amdgcn_rcpf(d.x); r.y = __builtin_amdgcn_rcpf(d.y);
                        const f32x2 h = (t * rs2) * r; w[2 * n + p] = cvt_pk_bf16(h.x, h.y); }
                u32x4 wv; wv.x = w[0]; wv.y = w[1]; wv.z = w[2]; wv.w = w[3];
                *(u32x4*)(H + ((size_t)((row >> 8) * nkt + (col0 >> 6)) * 256 + (row & 255)) * 64 + (col0 & 63)) = wv; }
    }
};
struct EpiResid {
    static constexpr bool PERM = true, AFTER_DRAIN = false;
    const float* base32; float* out32; bf16_t* xb; float* ssn; float alpha;
    __device__ __forceinline__ void operator()(const f32x4 (&acc)[2][2][4][2], const Unit& u, int wr, int wc, int fr, int fq) const {
        const int row0 = u.pm * BM + wr * 64 + fr, col0 = u.pn * BM + wc * 64 + 8 * fq;
        if (base32) {
#pragma unroll
            for (int ai = 0; ai < 2; ++ai) {
                f32x4 b[4][2][2];
#pragma unroll
                for (int m = 0; m < 4; ++m)
#pragma unroll
                    for (int bj = 0; bj < 2; ++bj) { const size_t off = (size_t)(row0 + ai * HALF + m * 16) * 1024 + col0 + bj * 32; b[m][bj][0] = *(const f32x4*)(base32 + off); b[m][bj][1] = *(const f32x4*)(base32 + off + 4); }
                __builtin_amdgcn_sched_barrier(0);
#pragma unroll
                for (int m = 0; m < 4; ++m) { const int row = row0 + ai * HALF + m * 16; float part = 0.f;
#pragma unroll
                    for (int bj = 0; bj < 2; ++bj) { const size_t off = (size_t)row * 1024 + col0 + bj * 32;
                        const f32x4 o0 = b[m][bj][0] + acc[ai][bj][m][0] * alpha, o1 = b[m][bj][1] + acc[ai][bj][m][1] * alpha;
                        u32x4 w; w.x = cvt_pk_bf16(o0[0], o0[1]); w.y = cvt_pk_bf16(o0[2], o0[3]); w.z = cvt_pk_bf16(o1[0], o1[1]); w.w = cvt_pk_bf16(o1[2], o1[3]);
                        *(u32x4*)(xb + off) = w;
                        part += (o0[0] * o0[0] + o0[1] * o0[1]) + (o0[2] * o0[2] + o0[3] * o0[3]) + (o1[0] * o1[0] + o1[1] * o1[1]) + (o1[2] * o1[2] + o1[3] * o1[3]); }
                    part += __shfl_xor(part, 16); part += __shfl_xor(part, 32); if (fq == 0) unsafeAtomicAdd(ssn + row, part); }
                __builtin_amdgcn_sched_barrier(0); }
            return; }
        u32x4 r[2][4][2];
#pragma unroll
        for (int ai = 0; ai < 2; ++ai)
#pragma unroll
            for (int m = 0; m < 4; ++m)
#pragma unroll
                for (int bj = 0; bj < 2; ++bj) r[ai][m][bj] = *(const u32x4*)(xb + (size_t)(row0 + ai * HALF + m * 16) * 1024 + col0 + bj * 32);
        __builtin_amdgcn_sched_barrier(0);
#pragma unroll
        for (int ai = 0; ai < 2; ++ai)
#pragma unroll
            for (int m = 0; m < 4; ++m) { const int row = row0 + ai * HALF + m * 16; float part = 0.f;
#pragma unroll
                for (int bj = 0; bj < 2; ++bj) { const size_t off = (size_t)row * 1024 + col0 + bj * 32; const u32x4 q = r[ai][m][bj];
                    const f32x4 b0 = (f32x4){__uint_as_float(q.x << 16), __uint_as_float(q.x & 0xffff0000u), __uint_as_float(q.y << 16), __uint_as_float(q.y & 0xffff0000u)};
                    const f32x4 b1 = (f32x4){__uint_as_float(q.z << 16), __uint_as_float(q.z & 0xffff0000u), __uint_as_float(q.w << 16), __uint_as_float(q.w & 0xffff0000u)};
                    const f32x4 o0 = b0 + acc[ai][bj][m][0] * alpha, o1 = b1 + acc[ai][bj][m][1] * alpha;
                    if (out32) { *(f32x4*)(out32 + off) = o0; *(f32x4*)(out32 + off + 4) = o1; }
                    else { u32x4 w; w.x = cvt_pk_bf16(o0[0], o0[1]); w.y = cvt_pk_bf16(o0[2], o0[3]); w.z = cvt_pk_bf16(o1[0], o1[1]); w.w = cvt_pk_bf16(o1[2], o1[3]);
                        *(u32x4*)(xb + off) = w;
                        part += (o0[0] * o0[0] + o0[1] * o0[1]) + (o0[2] * o0[2] + o0[3] * o0[3]) + (o1[0] * o1[0] + o1[1] * o1[1]) + (o1[2] * o1[2] + o1[3] * o1[3]); } }
                if (!out32) { part += __shfl_xor(part, 16); part += __shfl_xor(part, 32); if (fq == 0) unsafeAtomicAdd(ssn + row, part); } }
    }
};
struct EpiNull {
    static constexpr bool PERM = true, AFTER_DRAIN = false;
    float* sink;
    __device__ __forceinline__ void operator()(const f32x4 (&acc)[2][2][4][2], const Unit& u, int wr, int wc, int fr, int fq) const {
        float s = 0.f;
#pragma unroll
        for (int ai = 0; ai < 2; ++ai)
#pragma unroll
            for (int bj = 0; bj < 2; ++bj)
#pragma unroll
                for (int m = 0; m < 4; ++m)
#pragma unroll
                    for (int n = 0; n < 2; ++n) s += (acc[ai][bj][m][n][0] + acc[ai][bj][m][n][1]) + (acc[ai][bj][m][n][2] + acc[ai][bj][m][n][3]);
        if (s == 1.2345e33f) sink[0] = s;
    }
};
struct EpiWin {
    static constexpr bool PERM = true, AFTER_DRAIN = false;
    bf16_t *CU, *P, *Q, *Kq; const float* ss; const float *qg, *kg;
    __device__ __forceinline__ void operator()(const f32x4 (&acc)[2][2][4][2], const Unit& u, int wr, int wc, int fr, int fq) const {
        const int row0 = u.pm * BM + wr * 64 + fr, pn = u.pn;
        float rsv[2][4];
#pragma unroll
        for (int ai = 0; ai < 2; ++ai)
#pragma unroll
            for (int m = 0; m < 4; ++m) rsv[ai][m] = ss[row0 + ai * HALF + m * 16];
        __builtin_amdgcn_sched_barrier(0);
#pragma unroll
        for (int ai = 0; ai < 2; ++ai)
#pragma unroll
            for (int m = 0; m < 4; ++m) rsv[ai][m] = rsqrtf(rsv[ai][m] * (1.0f / 1024.0f) + NORM_EPS);
        if (pn < 2) {
#pragma unroll
            for (int ai = 0; ai < 2; ++ai)
#pragma unroll
                for (int m = 0; m < 4; ++m) { const int row = row0 + ai * HALF + m * 16; const float rs = rsv[ai][m]; float h[8];
#pragma unroll
                    for (int n = 0; n < 2; ++n)
#pragma unroll
                        for (int e = 0; e < 4; ++e) { const float a = acc[ai][0][m][n][e] * rs, g = acc[ai][1][m][n][e] * rs; h[4 * n + e] = a * fsigmoid(g); }
                    u32x4 w; w.x = cvt_pk_bf16(h[0], h[1]); w.y = cvt_pk_bf16(h[2], h[3]); w.z = cvt_pk_bf16(h[4], h[5]); w.w = cvt_pk_bf16(h[6], h[7]);
                    *(u32x4*)(CU + (size_t)row * 256 + pn * HALF + wc * 32 + 8 * fq) = w; }
        } else if (pn == 2) {
#pragma unroll
            for (int ai = 0; ai < 2; ++ai)
#pragma unroll
                for (int m = 0; m < 4; ++m) { const int row = row0 + ai * HALF + m * 16; const float rs = rsv[ai][m];
#pragma unroll
                    for (int bj = 0; bj < 2; ++bj) { const f32x4 v0 = acc[ai][bj][m][0] * rs, v1 = acc[ai][bj][m][1] * rs;
                        u32x4 w; w.x = cvt_pk_bf16(v0[0], v0[1]); w.y = cvt_pk_bf16(v0[2], v0[3]); w.z = cvt_pk_bf16(v1[0], v1[1]); w.w = cvt_pk_bf16(v1[2], v1[3]);
                        *(u32x4*)(P + (size_t)row * 256 + bj * HALF + wc * 32 + 8 * fq) = w; } }
        } else {
            const int which = (pn - 3) >> 1, head = 4 * ((pn - 3) & 1) + wc;
            const float* gp = (which ? kg : qg) + 8 * fq; const float post = which ? 1.0f : 0.125f;
            f32x4 gv[2][2];
#pragma unroll
            for (int bj = 0; bj < 2; ++bj)
#pragma unroll
                for (int n = 0; n < 2; ++n) gv[bj][n] = *(const f32x4*)(gp + 32 * bj + 4 * n) * post;
            bf16_t* dst = Q + head * 64 + 8 * fq;
#pragma unroll
            for (int ai = 0; ai < 2; ++ai)
#pragma unroll
                for (int m = 0; m < 4; ++m) { const int row = row0 + ai * HALF + m * 16; const float rs = rsv[ai][m];
                    f32x4 v[2][2]; float q = 0.f;
#pragma unroll
                    for (int bj = 0; bj < 2; ++bj)
#pragma unroll
                        for (int n = 0; n < 2; ++n) { v[bj][n] = acc[ai][bj][m][n] * rs; const f32x4 x = v[bj][n]; q += (x[0] * x[0] + x[1] * x[1]) + (x[2] * x[2] + x[3] * x[3]); }
                    q += __shfl_xor(q, 16); q += __shfl_xor(q, 32);
                    const float r2 = rsqrtf(q * (1.0f / 64.0f) + NORM_EPS);
#pragma unroll
                    for (int bj = 0; bj < 2; ++bj) { const f32x4 v0 = v[bj][0] * gv[bj][0] * r2, v1 = v[bj][1] * gv[bj][1] * r2;
                        u32x4 w; w.x = cvt_pk_bf16(v0[0], v0[1]); w.y = cvt_pk_bf16(v0[2], v0[3]); w.z = cvt_pk_bf16(v1[0], v1[1]); w.w = cvt_pk_bf16(v1[2], v1[3]);
                        if (which) { const int tb_ = row >> 12, ts_ = row & 4095, gr = ts_ >> 6, col = ts_ & 63;
                            *(u32x4*)(Kq + ((size_t)((tb_ * 8 + head) * 64 + gr) * 4096 + ((((col >> 2) & 1) * 2 + bj) * 8 + (col >> 3)) * 128 + (col & 3) * 32 + fq * 8)) = w; }
                        else *(u32x4*)(dst + (size_t)row * 512 + 32 * bj) = w; } }
        }
    }
};
struct EpiVT {
    static constexpr bool PERM = true, AFTER_DRAIN = false;
    bf16_t* VT; const float* ss; int ldv;
    __device__ __forceinline__ void operator()(const f32x4 (&acc)[2][2][4][2], const Unit& u, int wr, int wc, int fr, int fq) const {
        const int row0 = u.pm * BM + wr * 64 + fr, col0 = u.pn * BM + wc * 32 + 8 * fq;
        f32x4 rsv[2][2];
#pragma unroll
        for (int bj = 0; bj < 2; ++bj)
#pragma unroll
            for (int n = 0; n < 2; ++n) { const f32x4 s4 = *(const f32x4*)(ss + col0 + bj * HALF + 4 * n);
                rsv[bj][n] = (f32x4){rsqrtf(s4[0] * (1.0f / 1024.0f) + NORM_EPS), rsqrtf(s4[1] * (1.0f / 1024.0f) + NORM_EPS), rsqrtf(s4[2] * (1.0f / 1024.0f) + NORM_EPS), rsqrtf(s4[3] * (1.0f / 1024.0f) + NORM_EPS)}; }
#pragma unroll
        for (int ai = 0; ai < 2; ++ai)
#pragma unroll
            for (int m = 0; m < 4; ++m) { const int dim = row0 + ai * HALF + m * 16, hh = dim >> 6, d = dim & 63, jd = (d >> 2) & 3, frv = 4 * (d >> 4) + (d & 3);
#pragma unroll
                for (int bj = 0; bj < 2; ++bj) { const f32x4 v0 = acc[ai][bj][m][0] * rsv[bj][0], v1 = acc[ai][bj][m][1] * rsv[bj][1];
                    u32x4 w; w.x = cvt_pk_bf16(v0[0], v0[1]); w.y = cvt_pk_bf16(v0[2], v0[3]); w.z = cvt_pk_bf16(v1[0], v1[1]); w.w = cvt_pk_bf16(v1[2], v1[3]);
                    const int tok = col0 + bj * HALF, tb_ = tok >> 12, ts_ = tok & 4095, gr = ts_ >> 6, col = ts_ & 63;
                    *(u32x4*)(VT + ((size_t)((tb_ * 8 + hh) * 64 + gr) * 4096 + (jd * 8 + (col >> 3)) * 128 + frv * 8)) = w; } }
    }
};
template <class Epi, class Sched, bool ALIGN_EPI = false, bool SP2 = false>
__device__ __forceinline__ void gemm_phase(PG8_LAS unsigned char* lds, const Gemm g, const Sched& S, const Epi& E) {
    int tid_ = threadIdx.x; asm volatile("" : "+v"(tid_));
    const int tid = tid_, wid = __builtin_amdgcn_readfirstlane(tid >> 6), lane = tid & 63, wr = wid >> 2, wc = wid & 3, fr = lane & 15, fq = lane >> 4;
    const int K = g.K, nt = K / BK;
    unsigned voffA[2], voffB[2];
#pragma unroll
    for (int i = 0; i < 2; ++i) { int R, C; stage_rc(tid * 16 + i * 8192, R, C); const int Rb = Epi::PERM ? ((R & ~31) + perm32(R & 31)) : R;
        voffA[i] = (unsigned)(R * g.ldA + C) * 2u; voffB[i] = (unsigned)(Rb * g.ldB + C) * 2u; }
    const size_t kstep = (size_t)(BK * 2);
    const size_t hstep = (size_t)HALF * K * 2;
    const size_t tstep = 2 * hstep;
    const size_t kstepB = g.kstepB, hstepB = g.hstepB, tstepB = g.tstepB;
    const size_t kstepA = g.kstepA, hstepA = g.hstepA, tstepA = g.tstepA;
    const unsigned ldsw = (unsigned)wid * 1024u;
    const int aoff = lds_byte(wr * 64 + fr, fq * 8), boff = lds_byte(wc * 32 + fr, fq * 8);
#define PG8_SA(b, h) (((b) * 2 + (h)) * HTB)
#define PG8_SB(b, h) ((4 + (b) * 2 + (h)) * HTB)
#define PG8_STAGE(bufoff, gbase, voff) do { _Pragma("unroll") for (int _i = 0; _i < 2; ++_i) \
        __builtin_amdgcn_global_load_lds((const unsigned*)((const char*)(gbase) + (voff)[_i]), (PG8_LAS unsigned*)(lds + (bufoff) + ldsw + _i * 8192), 16, 0, 0); } while (0)
#define PG8_LDA(dst, b, h) do { _Pragma("unroll") for (int m = 0; m < 4; ++m) _Pragma("unroll") for (int k = 0; k < 2; ++k) dst[m][k] = *(const PG8_LAS bf16x8*)(lds + PG8_SA(b, h) + aoff + m * 2048 + k * 1024); } while (0)
#define PG8_LDB(dst, b, h) do { _Pragma("unroll") for (int n = 0; n < 2; ++n) _Pragma("unroll") for (int k = 0; k < 2; ++k) dst[n][k] = *(const PG8_LAS bf16x8*)(lds + PG8_SB(b, h) + boff + n * 2048 + k * 1024); } while (0)
#define PG8_MMA(ai, bj, At, Bt) do { __builtin_amdgcn_s_setprio(1); _Pragma("unroll") for (int m = 0; m < 4; ++m) _Pragma("unroll") for (int n = 0; n < 2; ++n) _Pragma("unroll") for (int k = 0; k < 2; ++k) \
        acc[ai][bj][m][n] = __builtin_amdgcn_mfma_f32_16x16x32_bf16(Bt[n][k], At[m][k], acc[ai][bj][m][n], 0, 0, 0); __builtin_amdgcn_s_setprio(0); } while (0)
#define PG8_WAIT_V(n) asm volatile("s_waitcnt vmcnt(" #n ")" ::: "memory")
#define PG8_WAIT_L(n) asm volatile("s_waitcnt lgkmcnt(" #n ")" ::: "memory")
#define PG8_BAR __builtin_amdgcn_s_barrier()
#define PG8_SCHED __builtin_amdgcn_sched_barrier(0)
    Unit cur, nxt; int ui = 0;
    if (!S.next(0, cur)) return;
    f32x4 acc[2][2][4][2];
#pragma unroll
    for (int a = 0; a < 2; ++a)
#pragma unroll
        for (int b = 0; b < 2; ++b)
#pragma unroll
            for (int m = 0; m < 4; ++m)
#pragma unroll
                for (int n = 0; n < 2; ++n) acc[a][b][m][n] = (f32x4){0.f, 0.f, 0.f, 0.f};
    bf16x8 At[4][2], B0[2][2], B1[2][2];
    const char* cA = (const char*)g.A + (size_t)cur.pm * tstepA; const char* cB = (const char*)g.Bt + (size_t)cur.pn * tstepB;
    S.a_ready(cur);
    if constexpr (SP2) {
        PG8_STAGE(PG8_SB(0, 0), cB, voffB); PG8_STAGE(PG8_SB(0, 1), cB + hstepB, voffB); PG8_STAGE(PG8_SA(0, 0), cA, voffA); PG8_STAGE(PG8_SA(0, 1), cA + hstepA, voffA);
        if (wr == 1) PG8_BAR;
        PG8_WAIT_V(2); PG8_BAR;
        PG8_STAGE(PG8_SB(1, 0), cB + kstepB, voffB); PG8_STAGE(PG8_SA(1, 0), cA + kstepA, voffA); PG8_STAGE(PG8_SB(1, 1), cB + hstepB + kstepB, voffB);
        PG8_WAIT_V(6); PG8_BAR;
    } else {
        PG8_STAGE(PG8_SB(0, 0), cB, voffB); PG8_STAGE(PG8_SA(0, 0), cA, voffA); PG8_STAGE(PG8_SB(0, 1), cB + hstepB, voffB); PG8_STAGE(PG8_SA(0, 1), cA + hstepA, voffA);
        if (wr == 1) PG8_BAR;
        PG8_WAIT_V(4); PG8_BAR;
        PG8_STAGE(PG8_SB(1, 0), cB + kstepB, voffB); PG8_STAGE(PG8_SA(1, 0), cA + kstepA, voffA); PG8_STAGE(PG8_SB(1, 1), cB + hstepB + kstepB, voffB);
        PG8_WAIT_V(6); PG8_BAR;
    }
    for (;;) {
        const bool has_next = S.next(ui + 1, nxt);
        const char* nA = has_next ? (const char*)g.A + (size_t)nxt.pm * tstepA : cA; const char* nB = has_next ? (const char*)g.Bt + (size_t)nxt.pn * tstepB : cB;
        for (int t = 0; t < nt; t += 2) {
            const bool last = (t == nt - 2);
            const char* a1 = cA + (size_t)(t + 1) * kstepA;
            const char* a2 = last ? nA : cA + (size_t)(t + 2) * kstepA; const char* b2 = last ? nB : cB + (size_t)(t + 2) * kstepB;
            const char* a3 = a2 + kstepA; const char* b3 = b2 + kstepB;
            if (last && has_next) S.a_ready(nxt);
            if constexpr (SP2) {
            PG8_LDB(B0, 0, 0); PG8_LDB(B1, 0, 1); PG8_SCHED; PG8_LDA(At, 0, 0); PG8_STAGE(PG8_SA(1, 1), a1 + hstepA, voffA);
            PG8_WAIT_V(8); PG8_WAIT_L(0); PG8_BAR; PG8_MMA(0, 0, At, B0); PG8_MMA(0, 1, At, B1); PG8_BAR; PG8_SCHED;
            PG8_LDA(At, 0, 1); PG8_STAGE(PG8_SB(0, 0), b2, voffB); PG8_STAGE(PG8_SB(0, 1), b2 + hstepB, voffB); PG8_STAGE(PG8_SA(0, 0), a2, voffA);
            PG8_WAIT_V(8); PG8_WAIT_L(0); PG8_BAR; PG8_MMA(1, 0, At, B0); PG8_MMA(1, 1, At, B1); PG8_BAR; PG8_SCHED;
            PG8_LDB(B0, 1, 0); PG8_LDB(B1, 1, 1); PG8_SCHED; PG8_LDA(At, 1, 0); PG8_STAGE(PG8_SA(0, 1), a2 + hstepA, voffA);
            PG8_WAIT_V(8); PG8_WAIT_L(0); PG8_BAR; PG8_MMA(0, 0, At, B0); PG8_MMA(0, 1, At, B1); PG8_BAR; PG8_SCHED;
            PG8_LDA(At, 1, 1); PG8_STAGE(PG8_SB(1, 0), b3, voffB); PG8_STAGE(PG8_SB(1, 1), b3 + hstepB, voffB); PG8_STAGE(PG8_SA(1, 0), a3, voffA);
            PG8_WAIT_V(8); PG8_WAIT_L(0); PG8_BAR; PG8_MMA(1, 0, At, B0); PG8_MMA(1, 1, At, B1); PG8_BAR; PG8_SCHED;
            } else {
            PG8_LDB(B0, 0, 0); PG8_SCHED; PG8_LDA(At, 0, 0); PG8_STAGE(PG8_SA(1, 1), a1 + hstepA, voffA);
            PG8_WAIT_L(8); PG8_BAR; PG8_WAIT_L(0); PG8_MMA(0, 0, At, B0); PG8_BAR; PG8_SCHED;
            PG8_LDB(B1, 0, 1); PG8_STAGE(PG8_SB(0, 0), b2, voffB);
            PG8_BAR; PG8_WAIT_L(0); PG8_MMA(0, 1, At, B1); PG8_BAR;
            PG8_LDA(At, 0, 1); PG8_STAGE(PG8_SA(0, 0), a2, voffA);
            PG8_BAR; PG8_WAIT_L(0); PG8_MMA(1, 0, At, B0); PG8_BAR; PG8_SCHED;
            PG8_STAGE(PG8_SB(0, 1), b2 + hstepB, voffB);
            PG8_WAIT_V(6); PG8_BAR; PG8_MMA(1, 1, At, B1); PG8_BAR;
            PG8_LDB(B0, 1, 0); PG8_SCHED; PG8_LDA(At, 1, 0); PG8_STAGE(PG8_SA(0, 1), a2 + hstepA, voffA);
            PG8_WAIT_L(8); PG8_BAR; PG8_WAIT_L(0); PG8_MMA(0, 0, At, B0); PG8_BAR; PG8_SCHED;
            PG8_LDB(B1, 1, 1); PG8_STAGE(PG8_SB(1, 0), b3, voffB);
            PG8_BAR; PG8_WAIT_L(0); PG8_MMA(0, 1, At, B1); PG8_BAR;
            PG8_LDA(At, 1, 1); PG8_STAGE(PG8_SA(1, 0), a3, voffA);
            PG8_BAR; PG8_WAIT_L(0); PG8_MMA(1, 0, At, B0); PG8_BAR; PG8_SCHED;
            PG8_STAGE(PG8_SB(1, 1), b3 + hstepB, voffB);
            PG8_WAIT_V(6); PG8_BAR; PG8_MMA(1, 1, At, B1); PG8_BAR;
            }
        }
        if constexpr (ALIGN_EPI) { if (wr == 0) PG8_BAR; }
        if constexpr (!Epi::AFTER_DRAIN) { E(acc, cur, wr, wc, fr, fq); S.done(cur); }
        if (!has_next) break;
#pragma unroll
        for (int a = 0; a < 2; ++a)
#pragma unroll
            for (int b = 0; b < 2; ++b)
#pragma unroll
                for (int m = 0; m < 4; ++m)
#pragma unroll
                    for (int n = 0; n < 2; ++n) acc[a][b][m][n] = (f32x4){0.f, 0.f, 0.f, 0.f};
        cur = nxt; cA = nA; cB = nB; ++ui;
        if constexpr (ALIGN_EPI) { if (wr == 1) PG8_BAR; }
    }
    PG8_WAIT_V(0);
    if constexpr (!ALIGN_EPI) { if (wr == 0) PG8_BAR; }
    PG8_BAR;
    if constexpr (Epi::AFTER_DRAIN) { E.fused(acc, cur, wr, wc, fr, fq, lds, wid, lane); S.done(cur); }
#undef PG8_SA
#undef PG8_SB
#undef PG8_STAGE
#undef PG8_LDA
#undef PG8_LDB
#undef PG8_MMA
#undef PG8_WAIT_V
#undef PG8_WAIT_L
#undef PG8_BAR
#undef PG8_SCHED
}
}

constexpr int DM = 1024, NB = 8, SEQ = 4096, MTOK = NB * SEQ, DFF = 2816, INW = 2304, NLAYER = 2, NHEAD = 8;
constexpr int NGU = 2 * DFF;
constexpr int NWIN = 1792;
constexpr float EPS = 1e-6f;
constexpr size_t MiB = 1u << 20;
constexpr size_t WS_CTL = 0, CTL_ZERO_BYTES = 262144; constexpr int CW_BAR = 4096;
constexpr size_t WS_SS = 1 * MiB;
constexpr size_t WS_W = 2 * MiB, W_LAYER = 40 * MiB;
constexpr size_t WO_GU1 = 0, WO_D1 = 11 * MiB, WO_WIN = WO_D1 + 5632 * 1024, WO_WV = WO_WIN + 3584 * 1024, WO_WO = WO_WV + 1 * MiB, WO_GU2 = WO_WO + 2 * MiB, WO_D2 = WO_GU2 + 11 * MiB;
static_assert(WO_D2 + 5632 * 1024 <= W_LAYER, "weights per layer");
constexpr size_t WS_XB = 82 * MiB;
constexpr size_t WS_H = 146 * MiB;
constexpr size_t WS_CU = WS_H, WS_P = WS_CU + 16 * MiB, WS_Q = WS_P + 16 * MiB, WS_K = WS_Q + 32 * MiB, WS_VT = WS_K + 32 * MiB;
constexpr size_t WS_Z = 322 * MiB, WS_END = 386 * MiB;
static_assert(WS_VT + 32 * MiB <= WS_Z && WS_W + 2 * W_LAYER <= WS_XB, "d_ws map");
constexpr int LDS_BYTES = 131072 + 30720 + 64;
constexpr int RPB_OFF = 131072, MISC_OFF = 131072 + 30720;

#define LAS __attribute__((address_space(3)))
typedef unsigned short bf16;
typedef unsigned v4u __attribute__((ext_vector_type(4)));
typedef unsigned v2u __attribute__((ext_vector_type(2)));
typedef float f32x4 __attribute__((ext_vector_type(4)));
typedef short bf16x8 __attribute__((ext_vector_type(8)));
#define LDS_WAIT() asm volatile("s_waitcnt lgkmcnt(0)" ::: "memory")
__device__ __forceinline__ float bf2f(unsigned short v) { return __uint_as_float((unsigned)v << 16); }
__device__ __forceinline__ unsigned pk2(float lo, float hi) { return pg8::cvt_pk_bf16(lo, hi); }
__device__ __forceinline__ float wave_sum(float v) {
#pragma unroll
    for (int o = 1; o < 64; o <<= 1) v += __shfl_xor(v, o);
    return v;
}

typedef __attribute__((address_space(1))) unsigned gu32;
#define RLX_AGENT __ATOMIC_RELAXED, __HIP_MEMORY_SCOPE_AGENT
#define XB_TMO      128
#define XB_XCNT(j)  (256  + 64 * (j))
#define XB_XSUB(j)  (1280 + 64 * (j))
#define XB_XGEN(j)  (2304 + 64 * (j))
#define XB_TOP      3328
#define XB_TOPGEN   3392
#define XCD_BAR_WORDS 3456
#define XB_SPIN_CAP (1u << 18)

__device__ __forceinline__ unsigned xb_ld(unsigned* p)              { return __hip_atomic_load(p, __ATOMIC_RELAXED, __HIP_MEMORY_SCOPE_AGENT); }
__device__ __forceinline__ unsigned xb_add(unsigned* p, unsigned v) { return __hip_atomic_fetch_add(p, v, __ATOMIC_RELAXED, __HIP_MEMORY_SCOPE_AGENT); }
__device__ __forceinline__ unsigned xb_xcc_id() { return (unsigned)__builtin_amdgcn_s_getreg((3 << 11) | 20) & 0xFu; }
#define XB_SPIN(cond, bar) do { unsigned _sp = 0; while (cond) { __builtin_amdgcn_s_sleep(1); \
    if ((++_sp & 255u) == 0u) { if (xb_ld(&(bar)[XB_TMO])) break; if (_sp > XB_SPIN_CAP) { atomicAdd(&(bar)[XB_TMO], 1u); break; } } } } while (0)

struct XcdBarrier {
    unsigned* bar; unsigned x; unsigned gsize;
    volatile LAS unsigned* st;
};

__device__ __forceinline__ XcdBarrier xcd_barrier_post(unsigned* bar, volatile LAS unsigned* st, unsigned gsize) {
    XcdBarrier b; b.bar = bar; b.x = xb_xcc_id(); b.st = st; b.gsize = gsize;
    if (threadIdx.x == 0) (void)xb_add(&bar[XB_XCNT(b.x)], 1u);
    return b;
}
__device__ __forceinline__ void xcd_barrier_complete(unsigned* bar, unsigned x, unsigned& nloc, unsigned& nx, unsigned G) {
    unsigned sum, cnt, mine, sp = 0u;
    for (;;) {
        sum = 0u; cnt = 0u; mine = 0u;
#pragma unroll
        for (unsigned j = 0; j < 16; ++j) { const unsigned c = xb_ld(&bar[XB_XCNT(j)]); sum += c; cnt += (c > 0u) ? 1u : 0u; mine = (j == x) ? c : mine; }
        if (sum == G) break;
        __builtin_amdgcn_s_sleep(1);
        if ((++sp & 255u) == 0u) { if (xb_ld(&bar[XB_TMO])) break; if (sp > XB_SPIN_CAP) { atomicAdd(&bar[XB_TMO], 1u); break; } }
    }
    nloc = mine > 0u ? mine : 1u; nx = cnt > 0u ? cnt : 1u;
}

__device__ __forceinline__ void xcd_barrier(const XcdBarrier& b) {
    asm volatile("s_waitcnt vmcnt(0)" ::: "memory");
    __syncthreads();
    if (threadIdx.x == 0) {
        unsigned* bar = b.bar;
        __builtin_amdgcn_s_waitcnt(0);
        unsigned nloc = b.st[0], nx = b.st[1];
        if (nloc == 0u) { xcd_barrier_complete(bar, b.x, nloc, nx, b.gsize); b.st[0] = nloc; b.st[1] = nx; }
        const unsigned old = xb_add(&bar[XB_XSUB(b.x)], 1u);
        const unsigned gen = old / nloc;
        if (old + 1u == (gen + 1u) * nloc) {
            __builtin_amdgcn_fence(__ATOMIC_RELEASE, "agent");
            asm volatile("s_waitcnt vmcnt(0)" ::: "memory");
            const unsigned og = xb_add(&bar[XB_TOP], 1u);
            const unsigned tg = og / nx;
            if (og + 1u == (tg + 1u) * nx) xb_add(&bar[XB_TOPGEN], 1u);
            else XB_SPIN(xb_ld(&bar[XB_TOPGEN]) == tg, bar);
            __builtin_amdgcn_fence(__ATOMIC_ACQUIRE, "agent");
            xb_add(&bar[XB_XGEN(b.x)], 1u);
            asm volatile("s_waitcnt vmcnt(0)" ::: "memory");
        } else {
            XB_SPIN(xb_ld(&bar[XB_XGEN(b.x)]) == gen, bar);
            __builtin_amdgcn_fence(__ATOMIC_ACQUIRE, "agent");
            asm volatile("s_waitcnt vmcnt(0)" ::: "memory");
        }
    }
    __syncthreads();
}

__device__ __forceinline__ int rescol32(int cc) { return (cc & ~255) | (((cc >> 5) & 3) << 6) | (((cc >> 7) & 1) << 5); }
__device__ __forceinline__ void tr_item(const float* W, int ldw, int srccol0, const float* g, bf16* Bt, int ldb, int dstrow0, int k0, int koff, LAS float* scr, int lane) {
    float tv[32]; const float* Wp = W + (size_t)(k0 + (lane >> 5)) * ldw + srccol0 + (lane & 31);
#pragma unroll
    for (int i = 0; i < 32; ++i) tv[i] = Wp[(size_t)(2 * i) * ldw];
    __builtin_amdgcn_sched_barrier(0);
#pragma unroll
    for (int i = 0; i < 32; ++i) { const int kk = 2 * i + (lane >> 5); float v = tv[i]; if (g) v *= g[k0 + kk]; scr[kk * 33 + (lane & 31)] = v; }
    LDS_WAIT(); asm volatile("" ::: "memory");
    const int c = lane & 7;
#pragma unroll
    for (int j = 0; j < 4; ++j) { const int n = (lane >> 3) + 8 * j; const LAS float* s = scr + (8 * c) * 33 + n;
        v4u o; o.x = pk2(s[0 * 33], s[1 * 33]); o.y = pk2(s[2 * 33], s[3 * 33]); o.z = pk2(s[4 * 33], s[5 * 33]); o.w = pk2(s[6 * 33], s[7 * 33]);
        const int rr = dstrow0 + n;
        *(v4u*)(Bt + ((size_t)((rr >> 8) * (ldb >> 6) + ((koff + k0) >> 6)) * 256 + (rr & 255)) * 64 + 8 * c) = o; }
    LDS_WAIT(); asm volatile("" ::: "memory");
}
__device__ __forceinline__ void fold_item(const float* L, int ldl, int kl0, const float* sc, const float* R, int J, bf16* Bt, int kd0, int n0, int lane) {
    float acc[8];
#pragma unroll
    for (int i = 0; i < 8; ++i) acc[i] = 0.f;
    const float* Lp = L + (size_t)kl0 * ldl; const float* Rp = R + n0 + lane;
#pragma unroll 1
    for (int j = 0; j < J; j += 16) { float wv[16];
#pragma unroll
        for (int u = 0; u < 16; ++u) wv[u] = Rp[(size_t)(j + u) * 1024];
        __builtin_amdgcn_sched_barrier(0);
#pragma unroll
        for (int u = 0; u < 16; ++u) { const float w = sc ? wv[u] * sc[j + u] : wv[u];
#pragma unroll
            for (int i = 0; i < 8; ++i) acc[i] += Lp[i * ldl + j + u] * w; } }
    v4u o; o.x = pk2(acc[0], acc[1]); o.y = pk2(acc[2], acc[3]); o.z = pk2(acc[4], acc[5]); o.w = pk2(acc[6], acc[7]);
    { const int n = n0 + lane, rr = (n & ~255) | (((n >> 5) & 1) << 7) | (((n >> 6) & 3) << 5) | (n & 31);
      *(v4u*)(Bt + ((size_t)((rr >> 8) * 16 + (kd0 >> 6)) * 256 + (rr & 255)) * 64 + (kd0 & 63)) = o; }
}

struct Args { const float* in[22]; float* out; unsigned char* ws; };
constexpr int I_GU = 16 * 176, I_D = 44 * 32, I_WIN = 16 * 56, I_WV = 16 * 16, I_WO = 8 * 32, I_FOLD = 1024;
constexpr int I_LAYER = 2 * I_GU + 2 * I_D + I_WIN + I_WV + I_WO + I_FOLD;

__device__ __forceinline__ void prologue(const Args& a, LAS unsigned char* lds, int gw, int NGW, int wave, int lane) {
    LAS float* scr = (LAS float*)(lds + wave * 16384);
    unsigned char* ws = a.ws;
    for (int it = gw; it < NLAYER * I_LAYER; it += NGW) {
        const int l = it / I_LAYER; int r = it % I_LAYER;
        unsigned char* wl = ws + WS_W + (size_t)l * W_LAYER;
        if (r < 2 * I_GU) {
            const int f = r / I_GU; r %= I_GU; const int kb = r / 176, nb = r % 176, cc = 32 * nb, pn = cc >> 8, bj = (cc >> 7) & 1, j = cc & 127;
            const float* Wg = a.in[f ? 19 : 2] + (size_t)l * DM * DFF; const float* Wu = a.in[f ? 20 : 3] + (size_t)l * DM * DFF; const float* g = a.in[f ? 18 : 1] + l * DM;
            tr_item(bj ? Wu : Wg, DFF, 128 * pn + j, g, (bf16*)(wl + (f ? WO_GU2 : WO_GU1)), DM, cc, 64 * kb, 0, scr, lane); continue; }
        r -= 2 * I_GU;
        if (r < 2 * I_D) { const int f = r / I_D; r %= I_D; const int kb = r / 32, nb = r % 32;
            tr_item(a.in[f ? 21 : 4] + (size_t)l * DFF * DM, DM, rescol32(32 * nb), nullptr, (bf16*)(wl + (f ? WO_D2 : WO_D1)), DFF, 32 * nb, 64 * kb, 0, scr, lane); continue; }
        r -= 2 * I_D;
        if (r < I_WIN) { const int kb = r / 56, nb = r % 56, cc = 32 * nb; int src;
            if (cc < 512) { const int pn = cc >> 8, bj = (cc >> 7) & 1, j = cc & 127; src = (bj ? 256 : 0) + 128 * pn + j; }
            else if (cc < 768) src = cc;
            else { const int t = cc - 768, which = t >> 9, t2 = t & 511, pn2 = t2 >> 8, bj = (t2 >> 7) & 1, wc = (t2 >> 5) & 3; src = 768 + which * 512 + 256 * pn2 + 64 * wc + 32 * bj; }
            tr_item(a.in[6] + (size_t)l * DM * INW, INW, src, a.in[5] + l * DM, (bf16*)(wl + WO_WIN), DM, cc, 64 * kb, 0, scr, lane); continue; }
        r -= I_WIN;
        if (r < I_WV) { const int kb = r / 16, nb = r % 16;
            tr_item(a.in[6] + (size_t)l * DM * INW, INW, 1792 + 32 * nb, a.in[5] + l * DM, (bf16*)(wl + WO_WV), DM, 32 * nb, 64 * kb, 0, scr, lane); continue; }
        r -= I_WV;
        const float* wout = a.in[17] + (size_t)l * DM * DM;
        if (r < I_WO) { const int kb = r / 32, nb = r % 32;
            tr_item(wout + (size_t)512 * DM, DM, rescol32(32 * nb), nullptr, (bf16*)(wl + WO_WO), DM, 32 * nb, 64 * kb, 512, scr, lane); continue; }
        r -= I_WO;
        { const int kg = r / 16, nb = r % 16, k0 = 8 * kg;
            if (k0 < 256) fold_item(a.in[11] + (size_t)l * 65536, 256, k0, nullptr, wout, 256, (bf16*)(wl + WO_WO), k0, 64 * nb, lane);
            else { const int gi = (k0 - 256) >> 6, c0 = (k0 - 256) & 63;
                fold_item(a.in[12] + (size_t)l * 16384 + gi * 4096, 64, c0, a.in[13] + l * 256 + 64 * gi, wout + (size_t)(256 + 64 * gi) * DM, 64, (bf16*)(wl + WO_WO), k0, 64 * nb, lane); } }
    }
    const float* x = a.in[0]; bf16* XB = (bf16*)(ws + WS_XB); float* SS = (float*)(ws + WS_SS);
    for (int m0 = gw * 4; m0 < MTOK; m0 += NGW * 4) {
        f32x4 v[4][4];
#pragma unroll
        for (int q = 0; q < 4; ++q) { const f32x4* xr = (const f32x4*)(x + (size_t)(m0 + q) * DM) + lane;
#pragma unroll
            for (int j = 0; j < 4; ++j) v[q][j] = xr[64 * j]; }
        __builtin_amdgcn_sched_barrier(0);
#pragma unroll
        for (int q = 0; q < 4; ++q) { float s = 0.f;
#pragma unroll
            for (int j = 0; j < 4; ++j) s += (v[q][j].x * v[q][j].x + v[q][j].y * v[q][j].y) + (v[q][j].z * v[q][j].z + v[q][j].w * v[q][j].w);
            s = wave_sum(s);
            v2u* o8 = (v2u*)(XB + (size_t)(m0 + q) * DM) + lane;
#pragma unroll
            for (int j = 0; j < 4; ++j) { v2u w; w.x = pk2(v[q][j].x, v[q][j].y); w.y = pk2(v[q][j].z, v[q][j].w); o8[64 * j] = w; }
            if (lane == 0) SS[m0 + q] = s; }
    }
    for (int i = gw * 64 + lane; i < 5 * MTOK; i += NGW * 64) SS[MTOK + i] = 0.f;
}

#define SCHED_FENCE() __builtin_amdgcn_sched_barrier(0)
__device__ __forceinline__ void attn_unit(int b, int h, int r, int cb, const bf16* Q, const bf16* K, const bf16* VT, const LAS float* rpbs, bf16* Z, int lane) {
    const int fr = lane & 15, fq = lane >> 4;
    const int r0 = min(max(r - 4, 0), 56), kstart = min(max(16 * cb - 8, 0), 32), qcol = 16 * cb + fr, c0 = min(max(qcol - 8, 0), 48);
    const size_t tokb = (size_t)b * SEQ;
    const bf16* qp = Q + (tokb + r * 64 + qcol) * 512 + h * 64 + 8 * fq;
    const bf16x8 q0 = *(const bf16x8*)qp, q1 = *(const bf16x8*)(qp + 32);
    const int g0 = kstart >> 3;
    const char* kb = (const char*)(K + ((size_t)((b * 8 + h) * 64 + r0) * 4096 + g0 * 128));
    const unsigned koff = (unsigned)(fr * 64 + fq * 16);
    bf16x8 kf[8][2][2];
#pragma unroll
    for (int i = 0; i < 8; ++i)
#pragma unroll
        for (int t = 0; t < 2; ++t)
#pragma unroll
            for (int ks = 0; ks < 2; ++ks) kf[i][t][ks] = *(const bf16x8*)(kb + (size_t)(i * 8192 + (t * 2 + ks) * 2048) + koff);
    SCHED_FENCE();
    f32x4 s[8][2];
#pragma unroll
    for (int i = 0; i < 8; ++i)
#pragma unroll
        for (int t = 0; t < 2; ++t) { f32x4 c = (f32x4){0.f, 0.f, 0.f, 0.f};
            c = __builtin_amdgcn_mfma_f32_16x16x32_bf16(kf[i][t][0], q0, c, 0, 0, 0); c = __builtin_amdgcn_mfma_f32_16x16x32_bf16(kf[i][t][1], q1, c, 0, 0, 0); s[i][t] = c; }
    SCHED_FENCE();
    const char* vb = (const char*)(VT + ((size_t)((b * 8 + h) * 64 + r0) * 4096 + g0 * 128));
    const unsigned voff = (unsigned)(fq * 256 + fr * 16);
    bf16x8 vf[8][4];
#pragma unroll
    for (int i = 0; i < 8; ++i)
#pragma unroll
        for (int jd = 0; jd < 4; ++jd) vf[i][jd] = *(const bf16x8*)(vb + (size_t)(i * 8192 + jd * 2048) + voff);
    SCHED_FENCE();
    float negm[8];
#pragma unroll
    for (int j = 0; j < 8; ++j) { const int kc = kstart + 8 * fq + j; negm[j] = ((kc >= c0) && (kc < c0 + 16)) ? 0.f : -1.0e30f; }
    float mx = -3.0e38f;
    const LAS float* bp0 = rpbs + (h * 15 + (r0 - r + 7)) * 64 + (kstart + 8 * fq - qcol + 15 + 16);
#pragma unroll
    for (int i = 0; i < 8; ++i) { float bv[8];
#pragma unroll
        for (int j = 0; j < 8; ++j) bv[j] = bp0[i * 64 + j];
#pragma unroll
        for (int t = 0; t < 2; ++t)
#pragma unroll
            for (int e = 0; e < 4; ++e) { const int j = 4 * t + e; const float v = (s[i][t][e] + bv[j]) + negm[j]; s[i][t][e] = v; mx = fmaxf(mx, v); } }
    mx = fmaxf(mx, __shfl_xor(mx, 16)); mx = fmaxf(mx, __shfl_xor(mx, 32));
    float l = 0.f; bf16x8 pb[8];
#pragma unroll
    for (int i = 0; i < 8; ++i) { float p[8];
#pragma unroll
        for (int t = 0; t < 2; ++t)
#pragma unroll
            for (int e = 0; e < 4; ++e) { const float pv = __expf(s[i][t][e] - mx); p[4 * t + e] = pv; l += pv; }
        v4u w; w.x = pk2(p[0], p[1]); w.y = pk2(p[2], p[3]); w.z = pk2(p[4], p[5]); w.w = pk2(p[6], p[7]);
        pb[i] = __builtin_bit_cast(bf16x8, w); }
    l += __shfl_xor(l, 16); l += __shfl_xor(l, 32);
    SCHED_FENCE();
    f32x4 o[4];
#pragma unroll
    for (int jd = 0; jd < 4; ++jd) o[jd] = (f32x4){0.f, 0.f, 0.f, 0.f};
#pragma unroll
    for (int i = 0; i < 8; ++i)
#pragma unroll
        for (int jd = 0; jd < 4; ++jd) o[jd] = __builtin_amdgcn_mfma_f32_16x16x32_bf16(vf[i][jd], pb[i], o[jd], 0, 0, 0);
    const float il = 1.0f / l;
    bf16* zp = Z + (tokb + r * 64 + qcol) * 1024 + 512 + h * 64 + 16 * fq;
    v4u w0, w1;
    w0.x = pk2(o[0][0] * il, o[0][1] * il); w0.y = pk2(o[0][2] * il, o[0][3] * il); w0.z = pk2(o[1][0] * il, o[1][1] * il); w0.w = pk2(o[1][2] * il, o[1][3] * il);
    w1.x = pk2(o[2][0] * il, o[2][1] * il); w1.y = pk2(o[2][2] * il, o[2][3] * il); w1.z = pk2(o[3][0] * il, o[3][1] * il); w1.w = pk2(o[3][2] * il, o[3][3] * il);
    *(v4u*)zp = w0; *(v4u*)(zp + 8) = w1;
    SCHED_FENCE();
}
__device__ __forceinline__ void conv_load(const bf16* cp, int tb, unsigned short (&raw)[38]) {
#pragma unroll
    for (int j = 0; j < 38; ++j) raw[j] = cp[(ptrdiff_t)(tb - 15) * 256 + j * 256];
}
__device__ __forceinline__ void conv_item(int item, const bf16* CU, const float* dw, const float* dwb, const float* lng, const float* lnb, bf16* Z, LAS float* st, int tid) {
    const int b = item >> 6, t0 = (item & 63) * 64, c = tid & 255, half = tid >> 8, lane = tid & 63, wave = tid >> 6;
    const bf16* cp = CU + (size_t)b * SEQ * 256 + c;
    unsigned short raw[38], rawn[38];
    conv_load(cp, t0 + half * 32, raw);
    float w[31];
#pragma unroll
    for (int k = 0; k < 31; ++k) w[k] = dw[k * 256 + c];
    const float bias = dwb[c];
#pragma unroll
    for (int ch = 0; ch < 4; ++ch) { const int tb = t0 + half * 32 + ch * 8;
        if (ch < 3) conv_load(cp, tb + 8, rawn);
        SCHED_FENCE();
        float in[38];
#pragma unroll
        for (int j = 0; j < 38; ++j) { const int tt = tb - 15 + j; in[j] = (tt >= 0 && tt < SEQ) ? bf2f(raw[j]) : 0.f; }
#pragma unroll
        for (int o = 0; o < 8; ++o) { float acc = bias;
#pragma unroll
            for (int k = 0; k < 31; ++k) acc += w[k] * in[o + k];
            st[(half * 32 + ch * 8 + o) * 256 + c] = acc; }
        SCHED_FENCE();
        if (ch < 3) {
#pragma unroll
            for (int j = 0; j < 38; ++j) raw[j] = rawn[j]; } }
    __syncthreads();
    const f32x4 g4 = *(const f32x4*)(lng + 4 * lane), b4 = *(const f32x4*)(lnb + 4 * lane);
    f32x4 v[8];
#pragma unroll
    for (int tt = 0; tt < 8; ++tt) v[tt] = *(const LAS f32x4*)(st + (8 * wave + tt) * 256 + 4 * lane);
#pragma unroll
    for (int tt = 0; tt < 8; ++tt) { const int tok = 8 * wave + tt;
        const float mean = wave_sum((v[tt].x + v[tt].y) + (v[tt].z + v[tt].w)) * (1.0f / 256.0f); const f32x4 d = v[tt] - mean;
        const float var = wave_sum((d.x * d.x + d.y * d.y) + (d.z * d.z + d.w * d.w)) * (1.0f / 256.0f); const float rstd = rsqrtf(var + EPS);
        f32x4 y = d * rstd * g4 + b4;
        y.x *= pg8::fsigmoid(y.x); y.y *= pg8::fsigmoid(y.y); y.z *= pg8::fsigmoid(y.z); y.w *= pg8::fsigmoid(y.w);
        v2u o; o.x = pk2(y.x, y.y); o.y = pk2(y.z, y.w);
        *(v2u*)(Z + ((size_t)b * SEQ + t0 + tok) * 1024 + 4 * lane) = o; }
    __syncthreads();
}
template <int W> __device__ __forceinline__ void pool_compute(const float (&in)[48], int tb, bf16* zp) {
#pragma unroll
    for (int o = 0; o < 32; ++o) { float sum = 0.f;
#pragma unroll
        for (int k = 0; k < W; ++k) sum += in[o + 8 - W / 2 + k];
        const int t = tb + o, lo = max(t - W / 2, 0), hi = min(t - W / 2 + W, SEQ);
        const float mixed = sum / (float)(hi - lo) - in[o + 8];
        zp[(size_t)o * 1024] = (bf16)(pk2(mixed, 0.f) & 0xffffu); }
}
__device__ __forceinline__ void pool_item(int item, const bf16* P, bf16* Z, int tid) {
    const int b = item >> 6, t0 = (item & 63) * 64, c = tid & 255, half = tid >> 8, g = __builtin_amdgcn_readfirstlane(c >> 6), tb = t0 + half * 32;
    const bf16* pc = P + (size_t)b * SEQ * 256 + c;
    unsigned short raw[48];
#pragma unroll
    for (int j = 0; j < 48; ++j) raw[j] = pc[(ptrdiff_t)(tb - 8) * 256 + j * 256];
    SCHED_FENCE();
    float in[48];
#pragma unroll
    for (int j = 0; j < 48; ++j) { const int tt = tb - 8 + j; in[j] = (tt >= 0 && tt < SEQ) ? bf2f(raw[j]) : 0.f; }
    bf16* zp = Z + ((size_t)b * SEQ + tb) * 1024 + 256 + c;
    if (g == 0) pool_compute<2>(in, tb, zp); else if (g == 1) pool_compute<4>(in, tb, zp); else if (g == 2) pool_compute<8>(in, tb, zp); else pool_compute<16>(in, tb, zp);
    SCHED_FENCE();
}

constexpr int NGRP = 8, MG = SEQ;
#ifndef WGM_G1
#define WGM_G1 4
#endif
#ifndef WGM_G2
#define WGM_G2 8
#endif
#ifndef WGM_G3
#define WGM_G3 8
#endif
#ifndef WGM_G4
#define WGM_G4 8
#endif
#ifndef WGM_VT
#define WGM_VT 2
#endif
#ifndef STAGGER_TICKS
#define STAGGER_TICKS 0
#endif
__device__ __forceinline__ int grp_opaque() { int g_ = (int)(blockIdx.x & 7u); asm volatile("" : "+s"(g_)); return g_; }
__device__ __forceinline__ XcdBarrier grp_bar(unsigned char* ws, LAS unsigned char* lds) {
    XcdBarrier b; b.bar = (unsigned*)(ws + WS_CTL) + CW_BAR + grp_opaque() * XCD_BAR_WORDS; b.x = xb_xcc_id(); b.st = (volatile LAS unsigned*)(lds + MISC_OFF); b.gsize = gridDim.x >> 3; return b; }
#define GP_TOK0   ((size_t)grp_opaque() * MG)
#define GP_SS(k)  ((float*)(a.ws + WS_SS) + (size_t)(k) * MTOK + GP_TOK0)
#define GP_XB     ((bf16*)(a.ws + WS_XB) + GP_TOK0 * DM)
#define GP_Z      ((bf16*)(a.ws + WS_Z) + GP_TOK0 * DM)
#define GP_HG     (a.ws + WS_H + (size_t)grp_opaque() * (22 * MiB))
#define GP_H      ((bf16*)GP_HG)
#define GP_CU     ((bf16*)GP_HG)
#define GP_P      ((bf16*)(GP_HG + 2 * MiB))
#define GP_Q      ((bf16*)(GP_HG + 4 * MiB))
#define GP_K      ((bf16*)(GP_HG + 8 * MiB))
#define GP_VT     ((bf16*)(GP_HG + 12 * MiB))
#define GROUP_BARRIER() xcd_barrier(grp_bar(a.ws, lds))
__global__ void __launch_bounds__(512, 2) fwd_megakernel(Args a) {
    extern __shared__ __attribute__((aligned(16))) unsigned char lds_raw[];
    LAS unsigned char* lds = (LAS unsigned char*)lds_raw;
    cg::grid_group grid = cg::this_grid();
    {
        const int tid = threadIdx.x, lane = tid & 63, wave = __builtin_amdgcn_readfirstlane(tid >> 6);
        const int G = gridDim.x, bid = blockIdx.x, vcu = (bid % 8) * (G / 8) + bid / 8;
        { volatile LAS unsigned* misc = (volatile LAS unsigned*)(lds + MISC_OFF); if (tid < 16) misc[tid] = 0u; }
        __syncthreads();
        prologue(a, lds, vcu * 8 + wave, G * 8, wave, lane);
        grid.sync();
        (void)xcd_barrier_post((unsigned*)(a.ws + WS_CTL) + CW_BAR + grp_opaque() * XCD_BAR_WORDS, (volatile LAS unsigned*)(lds + MISC_OFF), (unsigned)(G >> 3));
#if STAGGER_TICKS > 0
        { const int grp = grp_opaque(); if (grp) { const unsigned long long t0 = __builtin_amdgcn_s_memrealtime(); while (__builtin_amdgcn_s_memrealtime() - t0 < (unsigned long long)(grp * STAGGER_TICKS)) __builtin_amdgcn_s_sleep(8); } }
#endif
    }
#pragma unroll 1
    for (int step = 0; step < 2 * NLAYER; ++step) {
        const int l = step >> 1, f = step & 1;
        const int gc = (int)(blockIdx.x >> 3), Gg = (int)(gridDim.x >> 3);
        if (f == 1) {
            { unsigned char* wl = a.ws + WS_W + (size_t)l * W_LAYER;
              pg8::Gemm g = pg8::Gemm::make(GP_XB, false, (const bf16*)(wl + WO_WIN), true, MG, NWIN, DM); typedef pg8::GroupOrder<MG / 256, NWIN / 256, WGM_G3, 0> Ord; Ord S; S.init(Gg, gc);
              pg8::EpiWin E{GP_CU, GP_P, GP_Q, GP_K, GP_SS(3 * l + 1), a.in[14] + l * 64, a.in[15] + l * 64};
              pg8::gemm_phase<pg8::EpiWin, Ord, true, true>(lds, g, S, E); }
            { unsigned char* wl = a.ws + WS_W + (size_t)l * W_LAYER;
              pg8::Gemm g = pg8::Gemm::make((const bf16*)(wl + WO_WV), true, GP_XB, false, 512, MG, DM); typedef pg8::GroupOrder<2, MG / 256, WGM_VT, 0> Ord; Ord S; S.init(Gg, gc);
              pg8::EpiVT E{GP_VT, GP_SS(3 * l + 1), MG};
              pg8::gemm_phase<pg8::EpiVT, Ord, true, true>(lds, g, S, E); }
            GROUP_BARRIER();
            {
                int mt_ = threadIdx.x; asm volatile("" : "+v"(mt_));
                const int tid = mt_, lane = tid & 63, wave = __builtin_amdgcn_readfirstlane(tid >> 6);
                LAS float* rpbs = (LAS float*)(lds + RPB_OFF);
                const float* rpb = a.in[16] + (size_t)l * 3720;
                for (int i = tid; i < 8 * 15 * 64; i += 512) { const int dc = (i & 63) - 16; rpbs[i] = (dc >= 0 && dc < 31) ? rpb[(i >> 6) * 31 + dc] : 0.f; }
                __syncthreads();
                { const bf16* Qb = GP_Q; const bf16* Kb = GP_K; const bf16* VT = GP_VT; bf16* Z = GP_Z;
                  for (int it = gc; it < 256; it += Gg) { const int hh = it >> 5, rp = it & 31;
                      attn_unit(0, hh, 2 * rp + (wave >> 2), wave & 3, Qb, Kb, VT, rpbs, Z, lane); } }
                __syncthreads();
                { const bf16* CU = GP_CU; const bf16* P = GP_P; bf16* Z = GP_Z;
                  for (int it = gc; it < 64; it += Gg)
                      conv_item(it, CU, a.in[7] + (size_t)l * 31 * 256, a.in[8] + l * 256, a.in[9] + l * 256, a.in[10] + l * 256, Z, (LAS float*)lds, tid);
                  for (int it = gc; it < 64; it += Gg) pool_item(it, P, Z, tid); }
                __syncthreads();
            }
            GROUP_BARRIER();
            { unsigned char* wl = a.ws + WS_W + (size_t)l * W_LAYER;
              pg8::Gemm g = pg8::Gemm::make(GP_Z, false, (const bf16*)(wl + WO_WO), true, MG, DM, DM); typedef pg8::GroupOrder<MG / 256, DM / 256, WGM_G4, 0> Ord; Ord S; S.init(Gg, gc);
              pg8::EpiResid E{nullptr, nullptr, GP_XB, GP_SS(3 * l + 2), 1.0f};
              pg8::gemm_phase<pg8::EpiResid, Ord, true, true>(lds, g, S, E); }
            GROUP_BARRIER();
        }
        { unsigned char* wl = a.ws + WS_W + (size_t)l * W_LAYER;
          pg8::Gemm g = pg8::Gemm::make(GP_XB, false, (const bf16*)(wl + (f ? WO_GU2 : WO_GU1)), true, MG, NGU, DM); typedef pg8::GroupOrder<MG / 256, NGU / 256, WGM_G1, 0> Ord; Ord S; S.init(Gg, gc);
          pg8::EpiSwiglu E{GP_H, DFF / 64, GP_SS(3 * l + (f ? 2 : 0))};
#ifdef PROBE_G1NULL
          { pg8::EpiNull EN{GP_SS(5)}; pg8::gemm_phase<pg8::EpiNull, Ord, true, true>(lds, g, S, EN); }
#endif
          pg8::gemm_phase<pg8::EpiSwiglu, Ord, true, true>(lds, g, S, E); }
        GROUP_BARRIER();
        { unsigned char* wl = a.ws + WS_W + (size_t)l * W_LAYER;
          pg8::Gemm g = pg8::Gemm::make(GP_H, true, (const bf16*)(wl + (f ? WO_D2 : WO_D1)), true, MG, DM, DFF);   typedef pg8::GroupOrder<MG / 256, DM / 256, WGM_G2, 1> Ord; Ord S; S.init(Gg, gc);
          const bool last = (step == 2 * NLAYER - 1);
          pg8::EpiResid E{step == 0 ? a.in[0] + GP_TOK0 * DM : nullptr, last ? a.out + GP_TOK0 * DM : nullptr, GP_XB, last ? nullptr : GP_SS(f ? 3 * (l + 1) : 3 * l + 1), 0.5f};
#ifdef PROBE_G2NULL
          { pg8::EpiNull EN{GP_SS(5)}; pg8::gemm_phase<pg8::EpiNull, Ord, true, true>(lds, g, S, EN); }
#endif
          pg8::gemm_phase<pg8::EpiResid, Ord, true, true>(lds, g, S, E); }
        if (step != 2 * NLAYER - 1) GROUP_BARRIER();
    }
}

extern "C" void kernel_launch(void* const* d_in, const int* in_sizes, int n_in, void* d_out, int out_size, void* d_ws, size_t ws_size, hipStream_t stream) {
    static int grid = 0;
    if (grid == 0) {
        if (n_in != 22 || in_sizes[0] != MTOK * DM || out_size != MTOK * DM || ws_size < WS_END) { fprintf(stderr, "kernel_launch: unexpected shapes (n_in %d, in0 %d, out %d, ws %zu); nothing launched\n", n_in, n_in > 0 ? in_sizes[0] : -1, out_size, ws_size); grid = -1; return; }
        int dev = 0, cus = 0, per_cu = 0;
        if (hipGetDevice(&dev) != hipSuccess || hipDeviceGetAttribute(&cus, hipDeviceAttributeMultiprocessorCount, dev) != hipSuccess) { grid = -1; return; }
        if (hipFuncSetAttribute((const void*)fwd_megakernel, hipFuncAttributeMaxDynamicSharedMemorySize, LDS_BYTES) != hipSuccess) { fprintf(stderr, "kernel_launch: hipFuncSetAttribute failed\n"); grid = -1; return; }
        if (hipOccupancyMaxActiveBlocksPerMultiprocessor(&per_cu, (const void*)fwd_megakernel, 512, LDS_BYTES) != hipSuccess || per_cu < 1) { fprintf(stderr, "kernel_launch: occupancy query gave %d\n", per_cu); (void)hipGetLastError(); per_cu = 1; }
        grid = cus * 1; if (grid % 8 != 0 || grid < 8) { fprintf(stderr, "kernel_launch: %d CUs: the group program needs a multiple of 8 workgroups\n", grid); grid = -1; return; }
    }
    if (grid < 0) return;
    if (hipMemsetAsync((char*)d_ws + WS_CTL, 0, CTL_ZERO_BYTES, stream) != hipSuccess) { fprintf(stderr, "kernel_launch: hipMemsetAsync failed\n"); return; }
    Args a{};
    for (int i = 0; i < 22; ++i) a.in[i] = (const float*)d_in[i];
    a.out = (float*)d_out; a.ws = (unsigned char*)d_ws;
    void* args[] = {&a};
    hipError_t e = hipLaunchCooperativeKernel((const void*)fwd_megakernel, dim3(grid), dim3(512), args, LDS_BYTES, stream);
    if (e != hipSuccess) fprintf(stderr, "kernel_launch: cooperative launch failed: %s (grid %d)\n", hipGetErrorString(e), grid);
}
```
